# Optimizing an MI355X kernel written in HIP

```python
import jax, jax.numpy as jnp
from jax import lax
import numpy as np

D_MODEL = 1024
BATCH = 4
SEQ = 4096
DEPTH = 1

MLA_HEADS = 8
QK_NOPE_DIM = 64
QK_ROPE_DIM = 32
QK_HEAD_DIM = QK_NOPE_DIM + QK_ROPE_DIM
V_HEAD_DIM = 64
Q_LORA_RANK = 384
KV_LORA_RANK = 256
ROPE_BASE = 10000.0
Q_BLOCK = 128
HG_HEADS = 4
HG_KEY_DIM = 128
HG_VAL_DIM = 128
HG_WIDTH_K = HG_HEADS * HG_KEY_DIM
HG_WIDTH_V = HG_HEADS * HG_VAL_DIM
HG_CHUNK = 64
N_BRANCH = 2
BRANCH_WIDTH = MLA_HEADS * V_HEAD_DIM
FFN_HIDDEN = ((8 * D_MODEL // 3 + 255) // 256) * 256
PLE_DIM = 256
EPS = 1e-6

COL_SIZES = (Q_LORA_RANK, KV_LORA_RANK, QK_ROPE_DIM,
             HG_WIDTH_K, HG_WIDTH_K, HG_WIDTH_V, HG_WIDTH_V,
             N_BRANCH * D_MODEL)
IN_COLS = sum(COL_SIZES)

kernel_name = "hybrid_mla_hgrn2_gated_block"


def rms_norm(x, gain):
    xf = x.astype(jnp.float32)
    y = xf * lax.rsqrt(jnp.mean(xf * xf, axis=-1, keepdims=True) + EPS)
    return (y * gain.astype(jnp.float32)).astype(x.dtype)


def apply_rope(x, positions):
    r = x.shape[-1]
    half = r // 2
    inv_freq = jnp.exp(-jnp.log(ROPE_BASE) * jnp.arange(half, dtype=jnp.float32) * 2.0 / r)
    ang = positions.astype(jnp.float32)[..., None] * inv_freq
    cos = jnp.cos(ang)[:, :, None, :]
    sin = jnp.sin(ang)[:, :, None, :]
    xf = x.astype(jnp.float32)
    x1, x2 = xf[..., :half], xf[..., half:]
    out = jnp.concatenate([x1 * cos - x2 * sin, x2 * cos + x1 * sin], axis=-1)
    return out.astype(x.dtype)


def causal_block_attention(q, k, v):
    b, s, h, d = q.shape
    nb = s // Q_BLOCK
    qb = q.reshape(b, nb, Q_BLOCK, h, d).transpose(1, 0, 2, 3, 4)
    kpos = jnp.arange(s)
    scale = d ** -0.5

    def one_block(args):
        qi, bi = args
        sc = jnp.einsum('bqhd,bkhd->bhqk', qi, k, preferred_element_type=jnp.float32) * scale
        qpos = bi * Q_BLOCK + jnp.arange(Q_BLOCK)
        mask = kpos[None, :] <= qpos[:, None]
        sc = jnp.where(mask, sc, -jnp.inf)
        pr = jax.nn.softmax(sc, axis=-1).astype(v.dtype)
        return jnp.einsum('bhqk,bkhd->bqhd', pr, v)

    out = lax.map(one_block, (qb, jnp.arange(nb)))
    return out.transpose(1, 0, 2, 3, 4).reshape(b, s, h, v.shape[-1])


def hgrn2_chunked(q, k, v, log_f):
    b, s, h, kd = q.shape
    vd = v.shape[-1]
    nc = s // HG_CHUNK

    def to_chunks(t):
        return t.reshape(b, nc, HG_CHUNK, h, t.shape[-1]).transpose(1, 0, 3, 2, 4)

    qc, kc, vc, gc = to_chunks(q), to_chunks(k), to_chunks(v), to_chunks(log_f)
    causal = jnp.tril(jnp.ones((HG_CHUNK, HG_CHUNK), dtype=bool))[:, :, None]

    def step(state, inp):
        qi, ki, vi, gi = inp
        cum = jnp.cumsum(gi, axis=2)
        o_inter = jnp.einsum('bhck,bhkv->bhcv', qi * jnp.exp(cum), state)
        diff = cum[:, :, :, None, :] - cum[:, :, None, :, :]
        decay = jnp.exp(jnp.where(causal, diff, -jnp.inf))
        att = jnp.einsum('bhtk,bhsk,bhtsk->bhts', qi, ki, decay)
        o_intra = jnp.einsum('bhts,bhsv->bhtv', att, vi)
        last = cum[:, :, -1:, :]
        new_state = (jnp.exp(last[:, :, 0, :])[..., None] * state
                     + jnp.einsum('bhck,bhcv->bhkv', ki * jnp.exp(last - cum), vi))
        return new_state, o_inter + o_intra

    s0 = jnp.zeros((b, h, kd, vd), jnp.float32)
    _, o = lax.scan(step, s0, (qc, kc, vc, gc))
    return o.transpose(1, 0, 3, 2, 4).reshape(b, s, h, vd)


def setup_inputs(seed: int = 0) -> dict:
    key = jax.random.key(seed)
    ks = jax.random.split(key, 24)

    def w(k, shape, fan_in):
        return jax.random.normal(k, shape, jnp.float32) * (fan_in ** -0.5)

    def gain(k, shape):
        return 1.0 + 0.02 * jax.random.normal(k, shape, jnp.float32)

    x = jax.random.normal(ks[0], (BATCH, SEQ, D_MODEL), jnp.float32)
    p = jax.random.normal(ks[1], (DEPTH, BATCH, SEQ, PLE_DIM), jnp.float32)
    offsets = jax.random.randint(ks[2], (BATCH, 1), 0, 1024, dtype=jnp.int32)
    positions = offsets + jnp.arange(SEQ, dtype=jnp.int32)[None, :]
    return {
        "x": x,
        "p": p,
        "positions": positions,
        "mix_norm_g": gain(ks[3], (DEPTH, D_MODEL)),
        "w_in": w(ks[4], (DEPTH, D_MODEL, IN_COLS), D_MODEL),
        "q_a_norm_g": gain(ks[5], (DEPTH, Q_LORA_RANK)),
        "w_uq": w(ks[6], (DEPTH, Q_LORA_RANK, MLA_HEADS * QK_HEAD_DIM), Q_LORA_RANK),
        "kv_a_norm_g": gain(ks[7], (DEPTH, KV_LORA_RANK)),
        "w_ukv": w(ks[8], (DEPTH, KV_LORA_RANK, MLA_HEADS * (QK_NOPE_DIM + V_HEAD_DIM)), KV_LORA_RANK),
        "q_norm_g": gain(ks[9], (DEPTH, QK_HEAD_DIM)),
        "k_norm_g": gain(ks[10], (DEPTH, QK_HEAD_DIM)),
        "hg_lb_logits": 0.5 * jax.random.normal(ks[11], (DEPTH + 1, HG_WIDTH_K), jnp.float32),
        "hg_out_norm_g": gain(ks[12], (DEPTH, HG_VAL_DIM)),
        "w_branch": w(ks[13], (DEPTH, N_BRANCH, BRANCH_WIDTH, D_MODEL), BRANCH_WIDTH),
        "w_out": w(ks[14], (DEPTH, D_MODEL, D_MODEL), D_MODEL),
        "ffn_norm_g": gain(ks[15], (DEPTH, D_MODEL)),
        "w_ffn_gate": w(ks[16], (DEPTH, D_MODEL, FFN_HIDDEN), D_MODEL),
        "w_ffn_up": w(ks[17], (DEPTH, D_MODEL, FFN_HIDDEN), D_MODEL),
        "w_ffn_down": w(ks[18], (DEPTH, FFN_HIDDEN, D_MODEL), FFN_HIDDEN),
        "ple_gate_norm_g": gain(ks[19], (DEPTH, D_MODEL)),
        "w_ple_gate": w(ks[20], (DEPTH, D_MODEL, D_MODEL), D_MODEL),
        "w_ple_proj": w(ks[21], (DEPTH, PLE_DIM, D_MODEL), PLE_DIM),
        "ple_post_norm_g": gain(ks[22], (DEPTH, D_MODEL)),
    }


def reference(x, p, positions, mix_norm_g, w_in, q_a_norm_g, w_uq, kv_a_norm_g, w_ukv,
              q_norm_g, k_norm_g, hg_lb_logits, hg_out_norm_g, w_branch, w_out,
              ffn_norm_g, w_ffn_gate, w_ffn_up, w_ffn_down,
              ple_gate_norm_g, w_ple_gate, w_ple_proj, ple_post_norm_g):
    b, s, _ = x.shape
    split_points = np.cumsum(COL_SIZES)[:-1].tolist()
    lower_bounds = jnp.cumsum(jax.nn.softmax(hg_lb_logits.astype(jnp.float32), axis=0), axis=0)

    for layer in range(DEPTH):
        h = rms_norm(x, mix_norm_g[layer])
        proj = h @ w_in[layer]
        c_q, c_kv, k_rope_raw, hq, hf, hi, hg, br_gates = jnp.split(proj, split_points, axis=-1)

        q = (rms_norm(c_q, q_a_norm_g[layer]) @ w_uq[layer]).reshape(b, s, MLA_HEADS, QK_HEAD_DIM)
        kv = (rms_norm(c_kv, kv_a_norm_g[layer]) @ w_ukv[layer]).reshape(
            b, s, MLA_HEADS, QK_NOPE_DIM + V_HEAD_DIM)
        k_nope, v = kv[..., :QK_NOPE_DIM], kv[..., QK_NOPE_DIM:]
        k_rope = jnp.broadcast_to(k_rope_raw[:, :, None, :], (b, s, MLA_HEADS, QK_ROPE_DIM))
        k = jnp.concatenate([k_nope, k_rope], axis=-1)
        q = rms_norm(q, q_norm_g[layer])
        k = rms_norm(k, k_norm_g[layer])
        q = jnp.concatenate([q[..., :QK_NOPE_DIM], apply_rope(q[..., QK_NOPE_DIM:], positions)], axis=-1)
        k = jnp.concatenate([k[..., :QK_NOPE_DIM], apply_rope(k[..., QK_NOPE_DIM:], positions)], axis=-1)
        attn = causal_block_attention(q, k, v).reshape(b, s, BRANCH_WIDTH)

        lb = lower_bounds[layer]
        f = lb + (1.0 - lb) * jax.nn.sigmoid(hf.astype(jnp.float32))
        log_f = jnp.log(f)
        hk = 1.0 - f
        o = hgrn2_chunked(
            hq.astype(jnp.float32).reshape(b, s, HG_HEADS, HG_KEY_DIM),
            hk.reshape(b, s, HG_HEADS, HG_KEY_DIM),
            hi.astype(jnp.float32).reshape(b, s, HG_HEADS, HG_VAL_DIM),
            log_f.reshape(b, s, HG_HEADS, HG_KEY_DIM))
        o = rms_norm(o, hg_out_norm_g[layer]) * jax.nn.silu(
            hg.astype(jnp.float32).reshape(b, s, HG_HEADS, HG_VAL_DIM))
        rec = o.reshape(b, s, HG_WIDTH_V).astype(x.dtype)

        branches = jnp.stack([attn, rec], axis=2)
        y = jnp.einsum('bsgc,gcd->bsgd', branches, w_branch[layer])
        gates = jax.nn.sigmoid(br_gates.reshape(b, s, N_BRANCH, D_MODEL))
        x = x + jnp.sum(gates * y, axis=2) @ w_out[layer]

        h2 = rms_norm(x, ffn_norm_g[layer])
        x = x + (jax.nn.silu(h2 @ w_ffn_gate[layer]) * (h2 @ w_ffn_up[layer])) @ w_ffn_down[layer]

        e = rms_norm(p[layer] @ w_ple_proj[layer], ple_post_norm_g[layer])
        g = jax.nn.sigmoid(rms_norm(x, ple_gate_norm_g[layer]) @ w_ple_gate[layer])
        x = x + g * e
    return x
```

```cpp
#include <hip/hip_runtime.h>
#include <hip/hip_cooperative_groups.h>
#include <cstdio>
#include <cstdint>
namespace cg = cooperative_groups;
namespace pg8 {
#define PG8_LAS __attribute__((address_space(3)))
typedef unsigned short bf16_t;
typedef short bf16x8 __attribute__((ext_vector_type(8)));
typedef float f32x4 __attribute__((ext_vector_type(4)));
typedef unsigned u32x4 __attribute__((ext_vector_type(4)));
constexpr int BM = 256, BK = 64, HALF = 128, HTB = HALF * BK * 2  , STAGE_BYTES = 8 * HTB, NXCD = 8, WGM = 8;

__host__ __device__ __forceinline__ int lds_byte(int r, int c) { const int st = (r >> 4) * 2 + (c >> 5), rr = r & 15, cc = c & 31, ob = rr * 64 + cc * 2; return st * 1024 + (ob ^ (((ob >> 9) & 1) << 5)); }
__host__ __device__ __forceinline__ void stage_rc(int b, int& R, int& C) { const int st = b / 1024, sb = b % 1024, swz = sb ^ (((sb >> 9) & 1) << 5); R = (st >> 1) * 16 + swz / 64; C = (st & 1) * 32 + (swz % 64) / 2; }
__host__ __device__ __forceinline__ int perm32(int rho) { const int n = rho >> 4, i = rho & 15; return 8 * (i >> 2) + 4 * n + (i & 3); }

struct Unit { int pm, pn, kind = 0; };
struct Gemm { const bf16_t* A; const bf16_t* Bt; int M, N, K; const bf16_t* A1 = nullptr; const bf16_t* Bt1 = nullptr; };

struct StaticOrder {
    int nM, nN, nwg, G, c;
    __host__ __device__ void init(int M, int N, int G_, int c_) { nM = M / BM; nN = N / BM; nwg = nM * nN; G = G_; c = c_; }
    __host__ __device__ bool next(int i, Unit& u) const {
        const long L = (long)i * G + c; if (L >= nwg) return false;
        int wgid = (int)L; { const int q = nwg / NXCD, r = nwg % NXCD, xcd = wgid % NXCD, off = wgid / NXCD; wgid = (xcd < r ? xcd * (q + 1) : r * (q + 1) + (xcd - r) * q) + off; }
        const int nig = WGM * nN, gid = wgid / nig, fm = gid * WGM, gsz = (nM - fm) < WGM ? (nM - fm) : WGM;
        u.pm = fm + ((wgid % nig) % gsz); u.pn = (wgid % nig) / gsz; return true;
    }
    __device__ __forceinline__ void a_ready(const Unit&) const {}
    __device__ __forceinline__ void done(const Unit&) const {}
};


struct DualOrder {
    StaticOrder so;
    __host__ __device__ void init(int M, int N, int G_, int c_) { so.init(M, N, G_, c_); }
    __host__ __device__ bool next(int i, Unit& u) const { if (!so.next(i >> 1, u)) return false; u.kind = i & 1; return true; }
    __device__ __forceinline__ void a_ready(const Unit&) const {}
    __device__ __forceinline__ void done(const Unit&) const {}
};
struct SubOrder {
    int nN, nwg, first, nblk, c;
    __host__ __device__ void init(int M, int N, int G_, int c_, int first_) { nN = N / BM; nwg = (M / BM) * nN; first = first_; nblk = G_ - first_; c = c_; }
    __host__ __device__ bool next(int i, Unit& u) const { if (c < first) return false; const int L = i * nblk + (c - first); if (L >= nwg) return false; u.pm = L / nN; u.pn = L % nN; return true; }
    __device__ __forceinline__ void a_ready(const Unit&) const {}
    __device__ __forceinline__ void done(const Unit&) const {}
};
__device__ __forceinline__ unsigned cvt_pk_bf16(float lo, float hi) { unsigned r; asm volatile("v_cvt_pk_bf16_f32 %0, %1, %2" : "=v"(r) : "v"(lo), "v"(hi)); return r; }
constexpr float EPS_ = 1e-6f;
typedef float f32x2_t __attribute__((ext_vector_type(2))); typedef __bf16 bf16x2_t __attribute__((ext_vector_type(2)));
__device__ __forceinline__ unsigned cvtpk(float lo, float hi) { f32x2_t v = {lo, hi}; bf16x2_t b = __builtin_convertvector(v, bf16x2_t); return __builtin_bit_cast(unsigned, b); }
__device__ __forceinline__ u32x4 pack8(const f32x4 a, const f32x4 b) { u32x4 w; w.x = cvtpk(a[0], a[1]); w.y = cvtpk(a[2], a[3]); w.z = cvtpk(b[0], b[1]); w.w = cvtpk(b[2], b[3]); return w; }
__device__ __forceinline__ void unpack8(const u32x4 w, f32x4& a, f32x4& b) {
    a[0] = __uint_as_float(w.x << 16); a[1] = __uint_as_float(w.x & 0xffff0000u); a[2] = __uint_as_float(w.y << 16); a[3] = __uint_as_float(w.y & 0xffff0000u);
    b[0] = __uint_as_float(w.z << 16); b[1] = __uint_as_float(w.z & 0xffff0000u); b[2] = __uint_as_float(w.w << 16); b[3] = __uint_as_float(w.w & 0xffff0000u); }
__device__ __forceinline__ float sigm(float x) { return __builtin_amdgcn_rcpf(1.0f + __expf(-x)); }
__device__ __forceinline__ float sumsq8(const f32x4 a, const f32x4 b) { return (a[0] * a[0] + a[1] * a[1]) + (a[2] * a[2] + a[3] * a[3]) + (b[0] * b[0] + b[1] * b[1]) + (b[2] * b[2] + b[3] * b[3]); }
__device__ __forceinline__ float rowscale16(const float* ss, int row, float invn) {
    const f32x4* p = (const f32x4*)(ss + (size_t)row * 16); const f32x4 a = p[0], b = p[1], c = p[2], d = p[3];
    const float s = ((a[0] + a[1]) + (a[2] + a[3])) + ((b[0] + b[1]) + (b[2] + b[3])) + ((c[0] + c[1]) + (c[2] + c[3])) + ((d[0] + d[1]) + (d[2] + d[3]));
    return __builtin_amdgcn_rsqf(s * invn + EPS_); }
#define EPI_SIG const f32x4 (&acc)[2][2][4][2], const Unit& u, int wr, int wc, int fr, int fq
#define EPI_ROWS(ai, m) (u.pm * 256 + wr * 64 + fr + (ai) * 128 + (m) * 16)
#define EPI_FOR_ROWS _Pragma("unroll") for (int ai = 0; ai < 2; ++ai) _Pragma("unroll") for (int m = 0; m < 4; ++m)

struct EpiInProj {
    static constexpr bool PERM = true, AFTER_DRAIN = false, CHAIN = false;
    bf16_t *CQ, *CKV, *HQ, *HI, *SG; float *KR, *LOGF, *SSQ; const float* lbl;
    __device__ __forceinline__ void operator()(EPI_SIG) const {
        const int cw = wc * 32 + fq * 8;
#pragma unroll
        for (int bj = 0; bj < 2; ++bj) {
            const int hb = u.pn * 2 + bj;
            if (hb < 3 || hb == 4 || hb == 5) {
                bf16_t* dst; int ld, c0, slot;
                if (hb < 3) { dst = CQ; ld = 384; c0 = hb * 128 + cw; slot = hb * 4 + wc; } else { dst = CKV; ld = 256; c0 = (hb - 4) * 128 + cw; slot = 12 + (hb - 4) * 4 + wc; }
                EPI_FOR_ROWS { const int row = EPI_ROWS(ai, m); const f32x4 v0 = acc[ai][bj][m][0], v1 = acc[ai][bj][m][1];
                    float ss = sumsq8(v0, v1); ss += __shfl_xor(ss, 16); ss += __shfl_xor(ss, 32);
                    *(u32x4*)(dst + (size_t)row * ld + c0) = pack8(v0, v1);
                    if (fq == 0) SSQ[(size_t)row * 20 + slot] = ss; }
            } else if (hb == 3) {
                if (wc == 0) { EPI_FOR_ROWS { const int row = EPI_ROWS(ai, m); float* d = KR + (size_t)row * 32 + fq * 8; *(f32x4*)d = acc[ai][bj][m][0]; *(f32x4*)(d + 4) = acc[ai][bj][m][1]; } }
            } else if (hb < 10) {
                const int c0 = (hb - 6) * 128 + cw;
                EPI_FOR_ROWS { const int row = EPI_ROWS(ai, m); *(u32x4*)(HQ + (size_t)row * 512 + c0) = pack8(acc[ai][bj][m][0], acc[ai][bj][m][1]); }
            } else if (hb < 14) {
                const int c0 = (hb - 10) * 128 + cw;
                f32x4 lb[2];
#pragma unroll
                for (int n = 0; n < 2; ++n) { const f32x4 l0 = *(const f32x4*)(lbl + c0 + 4 * n), l1 = *(const f32x4*)(lbl + 512 + c0 + 4 * n);
#pragma unroll
                    for (int i = 0; i < 4; ++i) lb[n][i] = __builtin_amdgcn_rcpf(1.0f + __expf(l1[i] - l0[i])); }
                EPI_FOR_ROWS { const int row = EPI_ROWS(ai, m); f32x4 o[2];
#pragma unroll
                    for (int n = 0; n < 2; ++n)
#pragma unroll
                        for (int i = 0; i < 4; ++i) { const float f = lb[n][i] + (1.0f - lb[n][i]) * sigm(acc[ai][bj][m][n][i]); o[n][i] = __logf(f); }
                    float* d = LOGF + (size_t)row * 512 + c0; *(f32x4*)d = o[0]; *(f32x4*)(d + 4) = o[1]; }
            } else if (hb < 18) {
                const int c0 = (hb - 14) * 128 + cw;
                EPI_FOR_ROWS { const int row = EPI_ROWS(ai, m); *(u32x4*)(HI + (size_t)row * 512 + c0) = pack8(acc[ai][bj][m][0], acc[ai][bj][m][1]); }
            } else {
                const int c0 = (hb - 18) * 128 + cw;
                EPI_FOR_ROWS { const int row = EPI_ROWS(ai, m); f32x4 o[2];
#pragma unroll
                    for (int n = 0; n < 2; ++n)
#pragma unroll
                        for (int i = 0; i < 4; ++i) { const float v = acc[ai][bj][m][n][i]; o[n][i] = v * sigm(v); }
                    *(u32x4*)(SG + (size_t)row * 512 + c0) = pack8(o[0], o[1]); }
            }
        }
    }
};
struct EpiSigmoid {
    static constexpr bool PERM = true, AFTER_DRAIN = false, CHAIN = false;
    bf16_t* O; int ldc;
    __device__ __forceinline__ void operator()(EPI_SIG) const {
        const int cw = u.pn * 256 + wc * 32 + fq * 8;
        EPI_FOR_ROWS { const int row = EPI_ROWS(ai, m);
#pragma unroll
            for (int bj = 0; bj < 2; ++bj) { f32x4 o[2];
#pragma unroll
                for (int n = 0; n < 2; ++n)
#pragma unroll
                    for (int i = 0; i < 4; ++i) o[n][i] = sigm(acc[ai][bj][m][n][i]);
                *(u32x4*)(O + (size_t)row * ldc + cw + bj * 128) = pack8(o[0], o[1]); } }
    }
};
struct EpiGate2 {
    static constexpr bool PERM = true, AFTER_DRAIN = false, CHAIN = true;
    bf16_t* O; const bf16_t* G;
    __device__ __forceinline__ void chain(f32x4 (&acc)[2][2][4][2], const Unit& u, int wr, int wc, int fr, int fq) const {
        const int cw = u.pn * 256 + wc * 32 + fq * 8;
        EPI_FOR_ROWS { const int row = EPI_ROWS(ai, m);
#pragma unroll
            for (int bj = 0; bj < 2; ++bj) { const int col = cw + bj * 128;
                f32x4 a0, a1, b0, b1; unpack8(*(const u32x4*)(G + (size_t)row * 2048 + col), a0, a1); unpack8(*(const u32x4*)(G + (size_t)row * 2048 + 1024 + col), b0, b1);
#pragma unroll
                for (int i = 0; i < 4; ++i) { acc[ai][bj][m][0][i] *= a0[i] * __builtin_amdgcn_rcpf(fmaxf(b0[i], 1e-20f)); acc[ai][bj][m][1][i] *= a1[i] * __builtin_amdgcn_rcpf(fmaxf(b1[i], 1e-20f)); } } }
    }
    __device__ __forceinline__ void operator()(EPI_SIG) const {
        const int cw = u.pn * 256 + wc * 32 + fq * 8;
        EPI_FOR_ROWS { const int row = EPI_ROWS(ai, m);
#pragma unroll
            for (int bj = 0; bj < 2; ++bj) { const int col = cw + bj * 128;
                f32x4 b0, b1; unpack8(*(const u32x4*)(G + (size_t)row * 2048 + 1024 + col), b0, b1);
#pragma unroll
                for (int i = 0; i < 4; ++i) { b0[i] = fmaxf(b0[i], 1e-20f); b1[i] = fmaxf(b1[i], 1e-20f); }
                *(u32x4*)(O + (size_t)row * 1024 + col) = pack8(b0 * acc[ai][bj][m][0], b1 * acc[ai][bj][m][1]); } }
    }
};
struct EpiResidX {
    static constexpr bool PERM = true, AFTER_DRAIN = false, CHAIN = false;
    const float* base; bf16_t* outb; float* SS;
    __device__ __forceinline__ void operator()(EPI_SIG) const {
        const int cw = u.pn * 256 + wc * 32 + fq * 8;
        EPI_FOR_ROWS { const int row = EPI_ROWS(ai, m); float ss = 0.f;
#pragma unroll
            for (int bj = 0; bj < 2; ++bj) { const size_t off = (size_t)row * 1024 + cw + bj * 128;
                const f32x4 o0 = __builtin_nontemporal_load((const f32x4*)(base + off)) + acc[ai][bj][m][0], o1 = __builtin_nontemporal_load((const f32x4*)(base + off + 4)) + acc[ai][bj][m][1];
                *(u32x4*)(outb + off) = pack8(o0, o1); ss += sumsq8(o0, o1); }
            ss += __shfl_xor(ss, 16); ss += __shfl_xor(ss, 32);
            if (fq == 0) SS[(size_t)row * 16 + u.pn * 4 + wc] = ss; }
    }
};
struct EpiResidB {
    static constexpr bool PERM = true, AFTER_DRAIN = false, CHAIN = false;
    const bf16_t* base; bf16_t* outb; float* SS;
    __device__ __forceinline__ void operator()(EPI_SIG) const {
        const int cw = u.pn * 256 + wc * 32 + fq * 8;
        EPI_FOR_ROWS { const int row = EPI_ROWS(ai, m); float ss = 0.f;
#pragma unroll
            for (int bj = 0; bj < 2; ++bj) { const size_t off = (size_t)row * 1024 + cw + bj * 128;
                f32x4 b0, b1; unpack8(*(const u32x4*)(base + off), b0, b1);
                const f32x4 o0 = b0 + acc[ai][bj][m][0], o1 = b1 + acc[ai][bj][m][1];
                *(u32x4*)(outb + off) = pack8(o0, o1); ss += sumsq8(o0, o1); }
            ss += __shfl_xor(ss, 16); ss += __shfl_xor(ss, 32);
            if (fq == 0) SS[(size_t)row * 16 + u.pn * 4 + wc] = ss; }
    }
};
struct EpiSwiGLU {
    static constexpr bool PERM = true, AFTER_DRAIN = false, CHAIN = false;
    bf16_t* ACT; const float* SS;
    __device__ __forceinline__ void operator()(EPI_SIG) const {
        const int cw = u.pn * 128 + wc * 32 + fq * 8;
        EPI_FOR_ROWS { const int row = EPI_ROWS(ai, m); const float r = rowscale16(SS, row, 1.0f / 1024.0f), rl = r * -1.4426950408889634f, r2 = r * r; f32x4 o[2];
#pragma unroll
            for (int n = 0; n < 2; ++n)
#pragma unroll
                for (int i = 0; i < 4; ++i) { const float ag = acc[ai][0][m][n][i], au = acc[ai][1][m][n][i];
                    o[n][i] = (ag * au) * (r2 * __builtin_amdgcn_rcpf(1.0f + __builtin_amdgcn_exp2f(ag * rl))); }
            *(u32x4*)(ACT + (size_t)row * 2816 + cw) = pack8(o[0], o[1]); }
    }
};
struct EpiPE {
    static constexpr bool PERM = true, AFTER_DRAIN = false, CHAIN = false;
    bf16_t* PE; float* SS;
    __device__ __forceinline__ void operator()(EPI_SIG) const {
        const int cw = u.pn * 256 + wc * 32 + fq * 8;
        EPI_FOR_ROWS { const int row = EPI_ROWS(ai, m); float ss = 0.f;
#pragma unroll
            for (int bj = 0; bj < 2; ++bj) { *(u32x4*)(PE + (size_t)row * 1024 + cw + bj * 128) = pack8(acc[ai][bj][m][0], acc[ai][bj][m][1]); ss += sumsq8(acc[ai][bj][m][0], acc[ai][bj][m][1]); }
            ss += __shfl_xor(ss, 16); ss += __shfl_xor(ss, 32);
            if (fq == 0) SS[(size_t)row * 16 + u.pn * 4 + wc] = ss; }
    }
};
struct EpiFinal {
    static constexpr bool PERM = true, AFTER_DRAIN = false, CHAIN = false;
    float* out; const bf16_t* X2; const bf16_t* PE; const float *SS2, *SSP, *gpost;
    __device__ __forceinline__ void operator()(EPI_SIG) const {
        const int cw = u.pn * 256 + wc * 32 + fq * 8;
        EPI_FOR_ROWS { const int row = EPI_ROWS(ai, m); const float r2 = rowscale16(SS2, row, 1.0f / 1024.0f), re = rowscale16(SSP, row, 1.0f / 1024.0f);
#pragma unroll
            for (int bj = 0; bj < 2; ++bj) { const int col = cw + bj * 128; const size_t off = (size_t)row * 1024 + col;
                f32x4 e0, e1; unpack8(*(const u32x4*)(PE + off), e0, e1);
                f32x4 o0, o1; unpack8(*(const u32x4*)(X2 + off), o0, o1);
                const f32x4 g0 = *(const f32x4*)(gpost + col), g1 = *(const f32x4*)(gpost + col + 4);
#pragma unroll
                for (int i = 0; i < 4; ++i) { o0[i] += sigm(acc[ai][bj][m][0][i] * r2) * (e0[i] * re * g0[i]); o1[i] += sigm(acc[ai][bj][m][1][i] * r2) * (e1[i] * re * g1[i]); }
                __builtin_nontemporal_store(o0, (f32x4*)(out + off)); __builtin_nontemporal_store(o1, (f32x4*)(out + off + 4)); } }
    }
};

constexpr float QSCALE_ = 0.10206207261596577f * 1.4426950408889634f;
#define EPI_XBAR() do { asm volatile("s_waitcnt lgkmcnt(0)" ::: "memory"); __builtin_amdgcn_s_barrier(); asm volatile("" ::: "memory"); } while (0)
__device__ __forceinline__ float sum4(const f32x4 a) { return (a[0] + a[1]) + (a[2] + a[3]); }
typedef unsigned u32x2_ __attribute__((ext_vector_type(2)));
struct EpiQ {
    static constexpr bool PERM = true, AFTER_DRAIN = false, CHAIN = false;
    bf16_t* Q; const float *SSQ, *TAB, *g; PG8_LAS float* X;
    __device__ __forceinline__ void operator()(EPI_SIG) const {
        { int l_; asm volatile("v_mbcnt_lo_u32_b32 %0, -1, 0\n\tv_mbcnt_hi_u32_b32 %0, -1, %0" : "=v"(l_)); fr = l_ & 15; fq = l_ >> 4; }
        const int rt0 = wr * 64 + fr;
        EPI_FOR_ROWS { const int rt = rt0 + ai * 128 + m * 16;
#pragma unroll
            for (int bj = 0; bj < 2; ++bj) { float ss = sumsq8(acc[ai][bj][m][0], acc[ai][bj][m][1]); ss += __shfl_xor(ss, 16); ss += __shfl_xor(ss, 32); if (fq == 0) X[rt * 8 + bj * 4 + wc] = ss; } }
        EPI_XBAR();
        if (wc == 3) return;
        EPI_FOR_ROWS { const int row = EPI_ROWS(ai, m), rt = rt0 + ai * 128 + m * 16, b = row >> 12, s = row & 4095;
            const f32x4* sq = (const f32x4*)(SSQ + (size_t)row * 20);
            const float rq0 = __builtin_amdgcn_rsqf((sum4(sq[0]) + sum4(sq[1]) + sum4(sq[2])) * (1.0f / 384.0f) + EPS_);
#pragma unroll
            for (int bj = 0; bj < 2; ++bj) { const int head = 2 * u.pn + bj;
                const f32x4 xs = *(const PG8_LAS f32x4*)(X + rt * 8 + bj * 4);
                const float sc = __builtin_amdgcn_rsqf(sum4(xs) * rq0 * rq0 * (1.0f / 96.0f) + EPS_) * rq0 * QSCALE_;
                bf16_t* dst = Q + ((size_t)(b * 8 + head) * 4096 + s) * 96;
                if (wc < 2) { const int c = 32 * wc + 8 * fq; const f32x4 g0 = *(const f32x4*)(g + c), g1 = *(const f32x4*)(g + c + 4);
                    *(u32x4*)(dst + c) = pack8(acc[ai][bj][m][0] * sc * g0, acc[ai][bj][m][1] * sc * g1);
                } else { const int i0 = 4 * fq; const f32x4 g1 = *(const f32x4*)(g + 64 + i0), g2 = *(const f32x4*)(g + 80 + i0);
                    const f32x4 cs = *(const f32x4*)(TAB + (size_t)row * 32 + i0), sn = *(const f32x4*)(TAB + (size_t)row * 32 + 16 + i0);
                    const f32x4 x1 = acc[ai][bj][m][0] * sc * g1, x2 = acc[ai][bj][m][1] * sc * g2, o1 = x1 * cs - x2 * sn, o2 = x2 * cs + x1 * sn;
                    u32x2_ w1, w2; w1.x = cvtpk(o1[0], o1[1]); w1.y = cvtpk(o1[2], o1[3]); w2.x = cvtpk(o2[0], o2[1]); w2.y = cvtpk(o2[2], o2[3]);
                    *(u32x2_*)(dst + 64 + i0) = w1; *(u32x2_*)(dst + 80 + i0) = w2; }
            } asm volatile("" ::: "memory"); }
    }
};
struct EpiKV {
    static constexpr bool PERM = true, AFTER_DRAIN = false, CHAIN = false;
    bf16_t *K, *V; const float *SSQ, *TAB, *KR, *g; PG8_LAS float* X;
    __device__ __forceinline__ void operator()(EPI_SIG) const {
        { int l_; asm volatile("v_mbcnt_lo_u32_b32 %0, -1, 0\n\tv_mbcnt_hi_u32_b32 %0, -1, %0" : "=v"(l_)); fr = l_ & 15; fq = l_ >> 4; }
        const int rt0 = wr * 64 + fr;
        EPI_FOR_ROWS { const int rt = rt0 + ai * 128 + m * 16, row = EPI_ROWS(ai, m);
            if (wc < 2) {
#pragma unroll
                for (int bj = 0; bj < 2; ++bj) { float ss = sumsq8(acc[ai][bj][m][0], acc[ai][bj][m][1]); ss += __shfl_xor(ss, 16); ss += __shfl_xor(ss, 32); if (fq == 0) X[rt * 8 + bj * 4 + wc] = ss; }
            } else if (wc == 2) { const f32x4 a = *(const f32x4*)(KR + (size_t)row * 32 + 4 * fq), bq = *(const f32x4*)(KR + (size_t)row * 32 + 16 + 4 * fq);
                float ss = sumsq8(a, bq); ss += __shfl_xor(ss, 16); ss += __shfl_xor(ss, 32); if (fq == 0) X[rt * 8 + 3] = ss; }
            asm volatile("" ::: "memory");
        }
        EPI_XBAR();
        EPI_FOR_ROWS { const int row = EPI_ROWS(ai, m), rt = rt0 + ai * 128 + m * 16, b = row >> 12, s = row & 4095;
            const f32x4* sq = (const f32x4*)(SSQ + (size_t)row * 20 + 12);
            const float rkv = __builtin_amdgcn_rsqf((sum4(sq[0]) + sum4(sq[1])) * (1.0f / 256.0f) + EPS_);
            const f32x4 xa = *(const PG8_LAS f32x4*)(X + rt * 8), xb = *(const PG8_LAS f32x4*)(X + rt * 8 + 4);
#pragma unroll
            for (int bj = 0; bj < 2; ++bj) { const int head = 2 * u.pn + bj;
                const float nss = bj == 0 ? xa[0] + xa[1] : xb[0] + xb[1];
                const float rk = __builtin_amdgcn_rsqf((nss * rkv * rkv + xa[3]) * (1.0f / 96.0f) + EPS_);
                const size_t ri = (size_t)(b * 8 + head) * 4096 + s;
                if (wc < 2) { const int c = 32 * wc + 8 * fq; const f32x4 g0 = *(const f32x4*)(g + c), g1 = *(const f32x4*)(g + c + 4); const float sc = rkv * rk;
                    *(u32x4*)(K + ri * 96 + c) = pack8(acc[ai][bj][m][0] * sc * g0, acc[ai][bj][m][1] * sc * g1);
                } else { const int c = 32 * (wc - 2) + 8 * fq;
                    *(u32x4*)(V + ri * 64 + c) = pack8(acc[ai][bj][m][0] * rkv, acc[ai][bj][m][1] * rkv);
                    if (wc == 2) { const int i0 = 4 * fq; const f32x4 g1 = *(const f32x4*)(g + 64 + i0), g2 = *(const f32x4*)(g + 80 + i0);
                        const f32x4 cs = *(const f32x4*)(TAB + (size_t)row * 32 + i0), sn = *(const f32x4*)(TAB + (size_t)row * 32 + 16 + i0);
                        const f32x4 x1 = *(const f32x4*)(KR + (size_t)row * 32 + i0) * rk * g1, x2 = *(const f32x4*)(KR + (size_t)row * 32 + 16 + i0) * rk * g2, o1 = x1 * cs - x2 * sn, o2 = x2 * cs + x1 * sn;
                        u32x2_ w1, w2; w1.x = cvtpk(o1[0], o1[1]); w1.y = cvtpk(o1[2], o1[3]); w2.x = cvtpk(o2[0], o2[1]); w2.y = cvtpk(o2[2], o2[3]);
                        *(u32x2_*)(K + ri * 96 + 64 + i0) = w1; *(u32x2_*)(K + ri * 96 + 80 + i0) = w2; } }
            } asm volatile("" ::: "memory"); }
    }
};
template <class Epi, class Sched, bool ALIGN_EPI = false, bool SP2 = false>
__device__ __forceinline__ void gemm_phase(PG8_LAS unsigned char* lds, const Gemm g, const Sched& S, const Epi& E, const int wv_) {
    int tid_; asm volatile("v_mbcnt_lo_u32_b32 %0, -1, 0\n\tv_mbcnt_hi_u32_b32 %0, -1, %0" : "=v"(tid_)); tid_ += wv_ * 64;
    const int tid = tid_, wid = __builtin_amdgcn_readfirstlane(tid >> 6), lane = tid & 63, wr = wid >> 2, wc = wid & 3, fr = lane & 15, fq = lane >> 4;
    const int K = g.K, nt = K / BK;
    unsigned voffA[2], voffB[2];
#pragma unroll
    for (int i = 0; i < 2; ++i) { int R, C; stage_rc(tid * 16 + i * 8192, R, C); const int Rb = Epi::PERM ? ((R & ~31) + perm32(R & 31)) : R;
        voffA[i] = (unsigned)(R * K + C) * 2u; voffB[i] = (unsigned)(Rb * K + C) * 2u; }
    const size_t kstep = (size_t)(BK * 2);
    const size_t hstep = (size_t)HALF * K * 2;
    const size_t tstep = 2 * hstep;
    const unsigned ldsw = (unsigned)wid * 1024u;
    const int aoff = lds_byte(wr * 64 + fr, fq * 8), boff = lds_byte(wc * 32 + fr, fq * 8);
#define PG8_SA(b, h) (((b) * 2 + (h)) * HTB)
#define PG8_SB(b, h) ((4 + (b) * 2 + (h)) * HTB)
#define PG8_STAGE(bufoff, gbase, voff) do { _Pragma("unroll") for (int _i = 0; _i < 2; ++_i) \
        __builtin_amdgcn_global_load_lds((const unsigned*)((const char*)(gbase) + (voff)[_i]), (PG8_LAS unsigned*)(lds + (bufoff) + ldsw + _i * 8192), 16, 0, 0); } while (0)
#define PG8_LDA(dst, b, h) do { _Pragma("unroll") for (int m = 0; m < 4; ++m) _Pragma("unroll") for (int k = 0; k < 2; ++k) dst[m][k] = *(const PG8_LAS bf16x8*)(lds + PG8_SA(b, h) + aoff + m * 2048 + k * 1024); } while (0)
#define PG8_LDB(dst, b, h) do { _Pragma("unroll") for (int n = 0; n < 2; ++n) _Pragma("unroll") for (int k = 0; k < 2; ++k) dst[n][k] = *(const PG8_LAS bf16x8*)(lds + PG8_SB(b, h) + boff + n * 2048 + k * 1024); } while (0)
#define PG8_MMA(ai, bj, At, Bt) do { __builtin_amdgcn_s_setprio(1); _Pragma("unroll") for (int m = 0; m < 4; ++m) _Pragma("unroll") for (int n = 0; n < 2; ++n) _Pragma("unroll") for (int k = 0; k < 2; ++k) \
        acc[ai][bj][m][n] = __builtin_amdgcn_mfma_f32_16x16x32_bf16(Bt[n][k], At[m][k], acc[ai][bj][m][n], 0, 0, 0); __builtin_amdgcn_s_setprio(0); } while (0)
#define PG8_WAIT_V(n) asm volatile("s_waitcnt vmcnt(" #n ")" ::: "memory")
#define PG8_WAIT_L(n) asm volatile("s_waitcnt lgkmcnt(" #n ")" ::: "memory")
#define PG8_BAR __builtin_amdgcn_s_barrier()
#define PG8_SCHED __builtin_amdgcn_sched_barrier(0)
    Unit cur, nxt; int ui = 0;
    if (!S.next(0, cur)) return;
    f32x4 acc[2][2][4][2];
#pragma unroll
    for (int a = 0; a < 2; ++a)
#pragma unroll
        for (int b = 0; b < 2; ++b)
#pragma unroll
            for (int m = 0; m < 4; ++m)
#pragma unroll
                for (int n = 0; n < 2; ++n) acc[a][b][m][n] = (f32x4){0.f, 0.f, 0.f, 0.f};
    bf16x8 At[4][2], B0[2][2], B1[2][2];
    const char* cA = (const char*)(cur.kind ? g.A1 : g.A) + (size_t)cur.pm * tstep; const char* cB = (const char*)(cur.kind ? g.Bt1 : g.Bt) + (size_t)cur.pn * tstep;
    S.a_ready(cur);
    if constexpr (SP2) {
        PG8_STAGE(PG8_SB(0, 0), cB, voffB); PG8_STAGE(PG8_SB(0, 1), cB + hstep, voffB); PG8_STAGE(PG8_SA(0, 0), cA, voffA); PG8_STAGE(PG8_SA(0, 1), cA + hstep, voffA);
        if (wr == 1) PG8_BAR;
        PG8_WAIT_V(2); PG8_BAR;
        PG8_STAGE(PG8_SB(1, 0), cB + kstep, voffB); PG8_STAGE(PG8_SA(1, 0), cA + kstep, voffA); PG8_STAGE(PG8_SB(1, 1), cB + hstep + kstep, voffB);
        PG8_WAIT_V(6); PG8_BAR;
    } else {
        PG8_STAGE(PG8_SB(0, 0), cB, voffB); PG8_STAGE(PG8_SA(0, 0), cA, voffA); PG8_STAGE(PG8_SB(0, 1), cB + hstep, voffB); PG8_STAGE(PG8_SA(0, 1), cA + hstep, voffA);
        if (wr == 1) PG8_BAR;
        PG8_WAIT_V(4); PG8_BAR;
        PG8_STAGE(PG8_SB(1, 0), cB + kstep, voffB); PG8_STAGE(PG8_SA(1, 0), cA + kstep, voffA); PG8_STAGE(PG8_SB(1, 1), cB + hstep + kstep, voffB);
        PG8_WAIT_V(6); PG8_BAR;
    }
    for (;;) {
        const bool has_next = S.next(ui + 1, nxt);
        const char* nA = has_next ? (const char*)(nxt.kind ? g.A1 : g.A) + (size_t)nxt.pm * tstep : cA; const char* nB = has_next ? (const char*)(nxt.kind ? g.Bt1 : g.Bt) + (size_t)nxt.pn * tstep : cB;
        for (int t = 0; t < nt; t += 2) {
            const bool last = (t == nt - 2);
            const char* a1 = cA + (size_t)(t + 1) * kstep;
            const char* a2 = last ? nA : cA + (size_t)(t + 2) * kstep; const char* b2 = last ? nB : cB + (size_t)(t + 2) * kstep;
            const char* a3 = a2 + kstep; const char* b3 = b2 + kstep;
            if (last && has_next) S.a_ready(nxt);
            if constexpr (SP2) {
            PG8_LDB(B0, 0, 0); PG8_LDB(B1, 0, 1); PG8_SCHED; PG8_LDA(At, 0, 0); PG8_STAGE(PG8_SA(1, 1), a1 + hstep, voffA);
            PG8_WAIT_V(8); PG8_WAIT_L(0); PG8_BAR; PG8_MMA(0, 0, At, B0); PG8_MMA(0, 1, At, B1); PG8_BAR; PG8_SCHED;
            PG8_LDA(At, 0, 1); PG8_STAGE(PG8_SB(0, 0), b2, voffB); PG8_STAGE(PG8_SB(0, 1), b2 + hstep, voffB); PG8_STAGE(PG8_SA(0, 0), a2, voffA);
            PG8_WAIT_V(8); PG8_WAIT_L(0); PG8_BAR; PG8_MMA(1, 0, At, B0); PG8_MMA(1, 1, At, B1); PG8_BAR; PG8_SCHED;
            PG8_LDB(B0, 1, 0); PG8_LDB(B1, 1, 1); PG8_SCHED; PG8_LDA(At, 1, 0); PG8_STAGE(PG8_SA(0, 1), a2 + hstep, voffA);
            PG8_WAIT_V(8); PG8_WAIT_L(0); PG8_BAR; PG8_MMA(0, 0, At, B0); PG8_MMA(0, 1, At, B1); PG8_BAR; PG8_SCHED;
            PG8_LDA(At, 1, 1); PG8_STAGE(PG8_SB(1, 0), b3, voffB); PG8_STAGE(PG8_SB(1, 1), b3 + hstep, voffB); PG8_STAGE(PG8_SA(1, 0), a3, voffA);
            PG8_WAIT_V(8); PG8_WAIT_L(0); PG8_BAR; PG8_MMA(1, 0, At, B0); PG8_MMA(1, 1, At, B1); PG8_BAR; PG8_SCHED;
            } else {
            PG8_LDB(B0, 0, 0); PG8_SCHED; PG8_LDA(At, 0, 0); PG8_STAGE(PG8_SA(1, 1), a1 + hstep, voffA);
            PG8_WAIT_L(8); PG8_BAR; PG8_WAIT_L(0); PG8_MMA(0, 0, At, B0); PG8_BAR; PG8_SCHED;
            PG8_LDB(B1, 0, 1); PG8_STAGE(PG8_SB(0, 0), b2, voffB);
            PG8_BAR; PG8_WAIT_L(0); PG8_MMA(0, 1, At, B1); PG8_BAR;
            PG8_LDA(At, 0, 1); PG8_STAGE(PG8_SA(0, 0), a2, voffA);
            PG8_BAR; PG8_WAIT_L(0); PG8_MMA(1, 0, At, B0); PG8_BAR; PG8_SCHED;
            PG8_STAGE(PG8_SB(0, 1), b2 + hstep, voffB);
            PG8_WAIT_V(6); PG8_BAR; PG8_MMA(1, 1, At, B1); PG8_BAR;
            PG8_LDB(B0, 1, 0); PG8_SCHED; PG8_LDA(At, 1, 0); PG8_STAGE(PG8_SA(0, 1), a2 + hstep, voffA);
            PG8_WAIT_L(8); PG8_BAR; PG8_WAIT_L(0); PG8_MMA(0, 0, At, B0); PG8_BAR; PG8_SCHED;
            PG8_LDB(B1, 1, 1); PG8_STAGE(PG8_SB(1, 0), b3, voffB);
            PG8_BAR; PG8_WAIT_L(0); PG8_MMA(0, 1, At, B1); PG8_BAR;
            PG8_LDA(At, 1, 1); PG8_STAGE(PG8_SA(1, 0), a3, voffA);
            PG8_BAR; PG8_WAIT_L(0); PG8_MMA(1, 0, At, B0); PG8_BAR; PG8_SCHED;
            PG8_STAGE(PG8_SB(1, 1), b3 + hstep, voffB);
            PG8_WAIT_V(6); PG8_BAR; PG8_MMA(1, 1, At, B1); PG8_BAR;
            }
        }
        if constexpr (ALIGN_EPI) { if (wr == 0) PG8_BAR; }
        if constexpr (!Epi::AFTER_DRAIN) { if constexpr (Epi::CHAIN) { if (cur.kind == 0) E.chain(acc, cur, wr, wc, fr, fq); else E(acc, cur, wr, wc, fr, fq); } else { E(acc, cur, wr, wc, fr, fq); } S.done(cur); }
        if (!has_next) break;
        if (!(Epi::CHAIN && cur.kind == 0))
#pragma unroll
        for (int a = 0; a < 2; ++a)
#pragma unroll
            for (int b = 0; b < 2; ++b)
#pragma unroll
                for (int m = 0; m < 4; ++m)
#pragma unroll
                    for (int n = 0; n < 2; ++n) acc[a][b][m][n] = (f32x4){0.f, 0.f, 0.f, 0.f};
        cur = nxt; cA = nA; cB = nB; ++ui;
        if constexpr (ALIGN_EPI) { if (wr == 1) PG8_BAR; }
    }
    PG8_WAIT_V(0);
    if constexpr (!ALIGN_EPI) { if (wr == 0) PG8_BAR; }
    PG8_BAR;
    if constexpr (Epi::AFTER_DRAIN) { E.fused(acc, cur, wr, wc, fr, fq, lds, wid, lane); S.done(cur); }
#undef PG8_SA
#undef PG8_SB
#undef PG8_STAGE
#undef PG8_LDA
#undef PG8_LDB
#undef PG8_MMA
#undef PG8_WAIT_V
#undef PG8_WAIT_L
#undef PG8_BAR
#undef PG8_SCHED
}
}

#define LAS __attribute__((address_space(3)))
typedef unsigned short bf16;
typedef unsigned v4u __attribute__((ext_vector_type(4)));
typedef unsigned v2u __attribute__((ext_vector_type(2)));
typedef float f32x4 __attribute__((ext_vector_type(4)));
constexpr int NB = 4, SEQ = 4096, T = NB * SEQ, D = 1024, INC = 4768, FFH = 2816;
constexpr float EPS = 1e-6f;
constexpr float QSCALE = 0.10206207261596577f * 1.4426950408889634f;
constexpr size_t MiB = 1u << 20;
constexpr size_t WS_SSQ = 0;
constexpr size_t WS_DEC = 5 * MiB / 4;
constexpr size_t WS_CTL = 7 * MiB / 4;
constexpr size_t WS_WIN = 2 * MiB;
constexpr size_t WS_WUQ = WS_WIN + (size_t)4864 * 1024 * 2;
constexpr size_t WS_WUKV = WS_WUQ + (size_t)1024 * 384 * 2;
constexpr size_t WS_WBA = WS_WUKV + (size_t)1024 * 256 * 2;
constexpr size_t WS_WBB = WS_WBA + (size_t)1024 * 512 * 2;
constexpr size_t WS_WOUT = WS_WBB + (size_t)1024 * 512 * 2;
constexpr size_t WS_WGU = WS_WOUT + (size_t)1024 * 1024 * 2;
constexpr size_t WS_WD = WS_WGU + (size_t)5632 * 1024 * 2;
constexpr size_t WS_WPG = WS_WD + (size_t)1024 * 2816 * 2;
constexpr size_t WS_WPP = WS_WPG + (size_t)1024 * 1024 * 2;
constexpr size_t WS_WEND = WS_WPP + (size_t)1024 * 256 * 2;
static_assert(WS_WEND <= 36 * MiB, "weights");
constexpr size_t WS_PB = 36 * MiB;
constexpr size_t WS_H = 44 * MiB;
constexpr size_t WS_ATT = 76 * MiB;
constexpr size_t WS_HQ = 92 * MiB;
constexpr size_t WS_LOGF = 108 * MiB;
constexpr size_t WS_HI = 140 * MiB;
constexpr size_t WS_SG = 156 * MiB;
constexpr size_t WS_Q = 172 * MiB;
constexpr size_t WS_K = 196 * MiB;
constexpr size_t WS_V = 220 * MiB;
constexpr size_t WS_GATES = 172 * MiB;
constexpr size_t WS_REC = 236 * MiB;
constexpr size_t WS_ACT = 140 * MiB;
constexpr size_t WS_SS1 = 236 * MiB, WS_SS2 = 237 * MiB, WS_SSP = 238 * MiB;
constexpr size_t WS_TAB = 252 * MiB;
constexpr size_t WS_KR = 254 * MiB;
constexpr size_t DO_CQ = 0;
constexpr size_t DO_CKV = 12 * MiB;
constexpr size_t DO_ST = 24 * MiB;

constexpr int LDS_BYTES = 147456;

struct Params {
    const float *x, *p; const int* pos;
    const float *mix_g, *w_in, *qa_g, *w_uq, *kva_g, *w_ukv, *qn_g, *kn_g, *lbl, *hgo_g, *w_br, *w_out, *ffn_g, *w_fg, *w_fu, *w_fd, *pg_g, *w_pg, *w_pp, *pp_g;
    float* out; unsigned char* ws; int ph_lo, ph_hi;
};

__device__ __forceinline__ float bf2f(bf16 b) { return __uint_as_float((unsigned)b << 16); }
__device__ __forceinline__ unsigned f2bf(float f) { unsigned u = __float_as_uint(f); return (u + 0x7fffu + ((u >> 16) & 1u)) >> 16; }
__device__ __forceinline__ unsigned pk2(float lo, float hi) { return pg8::cvtpk(lo, hi); }
__device__ __forceinline__ float wave_sum(float v) {
#pragma unroll
    for (int o = 1; o < 64; o <<= 1) v += __shfl_xor(v, o);
    return v;
}
#define LDS_WAIT() asm volatile("s_waitcnt lgkmcnt(0)" ::: "memory")
#define LDS_BAR() do { asm volatile("s_waitcnt lgkmcnt(0)" ::: "memory"); __builtin_amdgcn_s_barrier(); asm volatile("" ::: "memory"); } while (0)
__device__ __forceinline__ int lane_v() { int l; asm volatile("v_mbcnt_lo_u32_b32 %0, -1, 0\n\tv_mbcnt_hi_u32_b32 %0, -1, %0" : "=v"(l)); return l; }
#define TIDX(wv) ((wv) * 64 + lane_v())

__device__ __forceinline__ void srcmap(const Params& P, int mat, int v, const float*& sp, int& ld) {
    sp = nullptr; ld = 0;
    switch (mat) {
    case 0: { int c;
        if (v < 384) c = v; else if (v < 416) c = 640 + (v - 384); else if (v < 512) c = -1; else if (v < 768) c = 384 + (v - 512);
        else if (v < 1280) c = 672 + (v - 768); else if (v < 1792) c = 1184 + (v - 1280); else if (v < 2304) c = 1696 + (v - 1792); else if (v < 2816) c = 2208 + (v - 2304);
        else c = 2720 + (v - 2816);
        ld = INC; if (c >= 0) sp = P.w_in + c; break; }
    case 1: { const int h = v >> 7, j = v & 127; int c;
        if (j < 64) c = h * 96 + j; else if (j < 96) { const int jj = j - 64, g = jj >> 3, w = jj & 7; c = h * 96 + (w < 4 ? 64 + g * 4 + w : 80 + g * 4 + (w - 4)); } else c = -1;
        ld = 768; if (c >= 0) sp = P.w_uq + c; break; }
    case 2: ld = 1024; sp = P.w_ukv + v; break;
    case 3: ld = 1024; sp = P.w_br + v; break;
    case 4: ld = 1024; sp = P.w_br + (size_t)512 * 1024 + v; break;
    case 5: ld = 1024; sp = P.w_out + v; break;
    case 6: { const int t = v >> 8, w = v & 255; ld = FFH; sp = (w < 128) ? P.w_fg + t * 128 + w : P.w_fu + t * 128 + (w - 128); break; }
    case 7: ld = 1024; sp = P.w_fd + v; break;
    case 8: ld = 1024; sp = P.w_pg + v; break;
    default: ld = 1024; sp = P.w_pp + v; break;
    }
}
__device__ __forceinline__ void tr_item(const Params& P, int mat, const float* gain, int K, bf16* WT, LAS float* scr, int kb, int nb, int lane) {
    const int k0 = 64 * kb, n0 = 32 * nb;
    const float* sp; int ld; srcmap(P, mat, n0 + (lane & 31), sp, ld);
    float tv[32];
#pragma unroll
    for (int i = 0; i < 32; ++i) { const int kk = 2 * i + (lane >> 5); tv[i] = sp ? __builtin_nontemporal_load(sp + (size_t)(k0 + kk) * ld) : 0.f; }
#pragma unroll
    for (int i = 0; i < 32; ++i) { const int kk = 2 * i + (lane >> 5); float v = tv[i]; if (gain) v *= gain[k0 + kk]; scr[kk * 33 + (lane & 31)] = v; }
    LDS_WAIT();
    const int c = lane & 7;
#pragma unroll
    for (int j = 0; j < 4; ++j) { const int n = (lane >> 3) + 8 * j; const LAS float* s = scr + (8 * c) * 33 + n;
        v4u o; o.x = pk2(s[0 * 33], s[1 * 33]); o.y = pk2(s[2 * 33], s[3 * 33]); o.z = pk2(s[4 * 33], s[5 * 33]); o.w = pk2(s[6 * 33], s[7 * 33]);
        *(v4u*)(WT + (size_t)(n0 + n) * K + k0 + 8 * c) = o; }
    LDS_WAIT();
}
__device__ __forceinline__ void prep_late_weights(const Params& P, LAS unsigned char* lds, const int wv, int first) {
    if ((int)blockIdx.x < first) return;
    const int lane = lane_v(), wave = wv;
    LAS float* scr = (LAS float*)(lds + wave * 16384);
    const int gw = ((int)blockIdx.x - first) * 8 + wave, NGW = ((int)gridDim.x - first) * 8;
    unsigned char* ws = P.ws;
    constexpr int NITEMS = 3008;
    for (int it = gw; it < NITEMS; it += NGW) {
        int r = it;
        if (r < 1024) { tr_item(P, 0, P.mix_g, 1024, (bf16*)(ws + WS_WIN), scr, r >> 6, 88 + (r & 63), lane); continue; } r -= 1024;
        if (r < 192) { tr_item(P, 1, P.qa_g, 384, (bf16*)(ws + WS_WUQ), scr, r >> 5, r & 31, lane); continue; } r -= 192;
        if (r < 128) { tr_item(P, 2, P.kva_g, 256, (bf16*)(ws + WS_WUKV), scr, r >> 5, r & 31, lane); continue; } r -= 128;
        if (r < 256) { tr_item(P, 3, nullptr, 512, (bf16*)(ws + WS_WBA), scr, r >> 5, r & 31, lane); continue; } r -= 256;
        if (r < 256) { tr_item(P, 4, nullptr, 512, (bf16*)(ws + WS_WBB), scr, r >> 5, r & 31, lane); continue; } r -= 256;
        if (r < 512) { tr_item(P, 5, nullptr, 1024, (bf16*)(ws + WS_WOUT), scr, r >> 5, r & 31, lane); continue; } r -= 512;
        if (r < 512) { tr_item(P, 8, P.pg_g, 1024, (bf16*)(ws + WS_WPG), scr, r >> 5, r & 31, lane); continue; } r -= 512;
        tr_item(P, 9, nullptr, 256, (bf16*)(ws + WS_WPP), scr, r >> 5, r & 31, lane);
    }
}
__device__ __forceinline__ void prep_wd(const Params& P, LAS unsigned char* lds, const int wv, int first) {
    if ((int)blockIdx.x < first) return;
    const int lane = lane_v(), wave = wv;
    LAS float* scr = (LAS float*)(lds + wave * 16384);
    const int gw = ((int)blockIdx.x - first) * 8 + wave, NGW = ((int)gridDim.x - first) * 8;
    for (int r = gw; r < 1408; r += NGW) tr_item(P, 7, nullptr, 2816, (bf16*)(P.ws + WS_WD), scr, r >> 5, r & 31, lane);
}
__device__ __forceinline__ void phase_prep(const Params& P, LAS unsigned char* lds, const int wv) {
    const int tid = TIDX(wv), lane = tid & 63, wave = tid >> 6;
    LAS float* scr = (LAS float*)(lds + wave * 16384);
    const int gw = blockIdx.x * 8 + wave, NGW = gridDim.x * 8;
    unsigned char* ws = P.ws;
    for (int it = gw; it < 1408; it += NGW) tr_item(P, 0, P.mix_g, 1024, (bf16*)(ws + WS_WIN), scr, it / 88, it % 88, lane);
    for (int it = gw; it < 2816; it += NGW) tr_item(P, 6, P.ffn_g, 1024, (bf16*)(ws + WS_WGU), scr, it / 176, it % 176, lane);
    bf16* H = (bf16*)(ws + WS_H); bf16* PB = (bf16*)(ws + WS_PB); float* TAB = (float*)(ws + WS_TAB);
    for (int m4 = gw * 4; m4 < T; m4 += NGW * 4) {
        f32x4 v[4][4]; f32x4 pv[4];
#pragma unroll
        for (int r = 0; r < 4; ++r) { const f32x4* xr = (const f32x4*)(P.x + (size_t)(m4 + r) * D) + lane;
#pragma unroll
            for (int j = 0; j < 4; ++j) v[r][j] = __builtin_nontemporal_load(xr + 64 * j);
            pv[r] = __builtin_nontemporal_load((const f32x4*)(P.p + (size_t)(m4 + r) * 256) + lane); }
#pragma unroll
        for (int r = 0; r < 4; ++r) { const int m = m4 + r; float s = 0.f;
#pragma unroll
            for (int j = 0; j < 4; ++j) s += (v[r][j][0] * v[r][j][0] + v[r][j][1] * v[r][j][1]) + (v[r][j][2] * v[r][j][2] + v[r][j][3] * v[r][j][3]);
            const float rr = 1.0f / sqrtf(wave_sum(s) * (1.0f / D) + EPS);
            v2u* o8 = (v2u*)(H + (size_t)m * D) + lane;
#pragma unroll
            for (int j = 0; j < 4; ++j) { v2u w; w.x = pk2(v[r][j][0] * rr, v[r][j][1] * rr); w.y = pk2(v[r][j][2] * rr, v[r][j][3] * rr); o8[64 * j] = w; }
            v2u w; w.x = pk2(pv[r][0], pv[r][1]); w.y = pk2(pv[r][2], pv[r][3]); *((v2u*)(PB + (size_t)m * 256) + lane) = w; }
        { const int m = m4 + (lane >> 4), l16 = lane & 15;
            double inv = 1.0; for (int i = 0; i < l16; ++i) inv *= 0.5623413251903491;
            const double rev = (double)P.pos[m] * inv * 0.15915494309189535; const float fr = (float)(rev - floor(rev));
            TAB[(size_t)m * 32 + l16] = __builtin_amdgcn_cosf(fr); TAB[(size_t)m * 32 + 16 + l16] = __builtin_amdgcn_sinf(fr); }
    }
}

typedef short bf16x8_t __attribute__((ext_vector_type(8)));
typedef short s16x4_t __attribute__((ext_vector_type(4)));
typedef float f32x16_t __attribute__((ext_vector_type(16)));
constexpr int AT_KRS = 208, AT_VRS = 144, AT_KBUF = 64 * AT_KRS, AT_VBUF = 64 * AT_VRS;
__device__ __forceinline__ int crow(int r, int hi) { return (r & 3) + 8 * (r >> 2) + 4 * hi; }
__device__ __forceinline__ s16x4_t vtr(const LAS unsigned char* p) { return __builtin_bit_cast(s16x4_t, __builtin_amdgcn_ds_read_tr16_b64_v4i16((LAS s16x4_t*)p)); }
__device__ __forceinline__ float max3_asm(float a, float b, float c) { float r; asm("v_max3_f32 %0, %1, %2, %3" : "=v"(r) : "v"(a), "v"(b), "v"(c)); return r; }
__device__ __forceinline__ void attn_unit(const Params& P, LAS unsigned char* lds, int bh, int qb, const int wv) {
    const int tid = TIDX(wv), lane = tid & 63, wave = wv, q32 = lane & 31, hi = lane >> 5;
    unsigned char* ws = P.ws;
    const bf16* Q = (const bf16*)(ws + WS_Q); const bf16* K = (const bf16*)(ws + WS_K); const bf16* V = (const bf16*)(ws + WS_V); bf16* ATT = (bf16*)(ws + WS_ATT);
    LAS unsigned char* kb0 = lds; LAS unsigned char* vb0 = lds + 2 * AT_KBUF;
    const int NT = 4 * (qb + 1);
    const v4u* Kg = (const v4u*)(K + (size_t)bh * SEQ * 96); const v4u* Vg = (const v4u*)(V + (size_t)bh * SEQ * 64);
    const int kc0 = tid, kc1 = tid + 512;
    const int kl0 = (kc0 / 12) * AT_KRS + (kc0 % 12) * 16, kl1 = (kc1 / 12) * AT_KRS + (kc1 % 12) * 16, vl = (tid >> 3) * AT_VRS + (tid & 7) * 16;
    bf16x8_t qf[6];
    { const bf16* Qw = Q + ((size_t)bh * SEQ + qb * 256 + wave * 32 + q32) * 96;
#pragma unroll
      for (int t = 0; t < 6; ++t) qf[t] = *(const bf16x8_t*)(Qw + 16 * t + 8 * hi); }
    f32x16_t o0, o1;
#pragma unroll
    for (int r = 0; r < 16; ++r) { o0[r] = 0.f; o1[r] = 0.f; }
    float lsum = 0.f;
    const int i16 = lane & 15, g16 = (lane >> 4) & 1;
    const int vlane = (4 * hi + (i16 >> 2)) * AT_VRS + (16 * g16 + 4 * (i16 & 3)) * 2;
    v4u ak0, ak1, av, bk0, bk1, bv;
#define AT_LOAD(k0_, k1_, v_, t_) do { k0_ = Kg[(size_t)(t_) * 768 + kc0]; if (tid < 256) k1_ = Kg[(size_t)(t_) * 768 + kc1]; v_ = Vg[(size_t)(t_) * 512 + tid]; } while (0)
#define AT_STORE(k0_, k1_, v_, buf_) do { LAS unsigned char* kbn_ = kb0 + (buf_) * AT_KBUF; LAS unsigned char* vbn_ = vb0 + (buf_) * AT_VBUF; \
        *(LAS v4u*)(kbn_ + kl0) = k0_; if (tid < 256) *(LAS v4u*)(kbn_ + kl1) = k1_; *(LAS v4u*)(vbn_ + vl) = v_; } while (0)
#define AT_PACK(pk_, sv_, b_) do { v4u w_; _Pragma("unroll") for (int jj = 0; jj < 4; ++jj) w_[jj] = pk2(sv_[(b_) + 2 * jj], sv_[(b_) + 2 * jj + 1]); pk_ = __builtin_bit_cast(bf16x8_t, w_); } while (0)
#define AT_COMPUTE(cur_, kt_) do { \
        const int jrel = (kt_) - 4 * qb; \
        if (jrel * 64 <= wave * 32 + 31) { \
            const LAS unsigned char* kb = kb0 + (cur_) * AT_KBUF; const LAS unsigned char* vb = vb0 + (cur_) * AT_VBUF; \
            bf16x8_t vf[8]; \
            _Pragma("unroll") for (int s = 0; s < 4; ++s) _Pragma("unroll") for (int db = 0; db < 2; ++db) { \
                const s16x4_t lo = vtr(vb + vlane + (16 * s) * AT_VRS + db * 64); const s16x4_t hi4 = vtr(vb + vlane + (16 * s + 8) * AT_VRS + db * 64); \
                vf[2 * s + db] = __builtin_shufflevector(lo, hi4, 0, 1, 2, 3, 4, 5, 6, 7); } \
            f32x16_t s0, s1; \
            _Pragma("unroll") for (int r = 0; r < 16; ++r) { s0[r] = 0.f; s1[r] = 0.f; } \
            _Pragma("unroll") for (int t = 0; t < 6; ++t) { \
                const bf16x8_t a0 = *(const LAS bf16x8_t*)(kb + q32 * AT_KRS + (16 * t + 8 * hi) * 2); \
                s0 = __builtin_amdgcn_mfma_f32_32x32x16_bf16(a0, qf[t], s0, 0, 0, 0); } \
            _Pragma("unroll") for (int t = 0; t < 6; ++t) { \
                const bf16x8_t a1 = *(const LAS bf16x8_t*)(kb + (q32 + 32) * AT_KRS + (16 * t + 8 * hi) * 2); \
                s1 = __builtin_amdgcn_mfma_f32_32x32x16_bf16(a1, qf[t], s1, 0, 0, 0); } \
            bf16x8_t pb0, pb1, pb2, pb3; float ps = 0.f; \
            if (jrel >= 0) {                            \
                const int qrel = wave * 32 + q32; \
                _Pragma("unroll") for (int r = 0; r < 16; ++r) { const int kr = jrel * 64 + crow(r, hi); s0[r] = (kr > qrel) ? 0.f : __builtin_amdgcn_exp2f(s0[r]); s1[r] = (kr + 32 > qrel) ? 0.f : __builtin_amdgcn_exp2f(s1[r]); ps += s0[r] + s1[r]; } \
                AT_PACK(pb0, s0, 0); AT_PACK(pb1, s0, 8); AT_PACK(pb2, s1, 0); AT_PACK(pb3, s1, 8); \
                o0 = __builtin_amdgcn_mfma_f32_32x32x16_bf16(vf[0], pb0, o0, 0, 0, 0); o1 = __builtin_amdgcn_mfma_f32_32x32x16_bf16(vf[1], pb0, o1, 0, 0, 0); \
                o0 = __builtin_amdgcn_mfma_f32_32x32x16_bf16(vf[2], pb1, o0, 0, 0, 0); o1 = __builtin_amdgcn_mfma_f32_32x32x16_bf16(vf[3], pb1, o1, 0, 0, 0); \
                o0 = __builtin_amdgcn_mfma_f32_32x32x16_bf16(vf[4], pb2, o0, 0, 0, 0); o1 = __builtin_amdgcn_mfma_f32_32x32x16_bf16(vf[5], pb2, o1, 0, 0, 0); \
                o0 = __builtin_amdgcn_mfma_f32_32x32x16_bf16(vf[6], pb3, o0, 0, 0, 0); o1 = __builtin_amdgcn_mfma_f32_32x32x16_bf16(vf[7], pb3, o1, 0, 0, 0); \
            } else { \
                _Pragma("unroll") for (int r = 0; r < 16; ++r) { s0[r] = __builtin_amdgcn_exp2f(s0[r]); ps += s0[r]; } \
                AT_PACK(pb0, s0, 0); AT_PACK(pb1, s0, 8); \
                o0 = __builtin_amdgcn_mfma_f32_32x32x16_bf16(vf[0], pb0, o0, 0, 0, 0); o1 = __builtin_amdgcn_mfma_f32_32x32x16_bf16(vf[1], pb0, o1, 0, 0, 0); \
                o0 = __builtin_amdgcn_mfma_f32_32x32x16_bf16(vf[2], pb1, o0, 0, 0, 0); o1 = __builtin_amdgcn_mfma_f32_32x32x16_bf16(vf[3], pb1, o1, 0, 0, 0); \
                _Pragma("unroll") for (int r = 0; r < 16; ++r) { s1[r] = __builtin_amdgcn_exp2f(s1[r]); ps += s1[r]; } \
                AT_PACK(pb2, s1, 0); AT_PACK(pb3, s1, 8); \
                o0 = __builtin_amdgcn_mfma_f32_32x32x16_bf16(vf[4], pb2, o0, 0, 0, 0); o1 = __builtin_amdgcn_mfma_f32_32x32x16_bf16(vf[5], pb2, o1, 0, 0, 0); \
                o0 = __builtin_amdgcn_mfma_f32_32x32x16_bf16(vf[6], pb3, o0, 0, 0, 0); o1 = __builtin_amdgcn_mfma_f32_32x32x16_bf16(vf[7], pb3, o1, 0, 0, 0); \
            } \
            lsum += ps; \
        } } while (0)
    AT_LOAD(ak0, ak1, av, 0);
    AT_LOAD(bk0, bk1, bv, 1);
    LDS_BAR();
    AT_STORE(ak0, ak1, av, 0);
    LDS_BAR();
    for (int kt = 0; kt < NT; kt += 2) {
        if (kt + 2 < NT) AT_LOAD(ak0, ak1, av, kt + 2);
        AT_COMPUTE(0, kt);
        AT_STORE(bk0, bk1, bv, 1);
        LDS_BAR();
        if (kt + 3 < NT) AT_LOAD(bk0, bk1, bv, kt + 3);
        AT_COMPUTE(1, kt + 1);
        if (kt + 2 < NT) AT_STORE(ak0, ak1, av, 0);
        LDS_BAR();
    }
#undef AT_LOAD
#undef AT_STORE
#undef AT_COMPUTE
#undef AT_PACK
    lsum += __shfl_xor(lsum, 32);
    const float il = 1.0f / lsum;
    const int b = bh >> 3, h = bh & 7;
    bf16* orow = ATT + ((size_t)b * SEQ + qb * 256 + wave * 32 + q32) * 512 + h * 64;
#pragma unroll
    for (int g = 0; g < 4; ++g) { v2u w0, w1;
        w0.x = pk2(o0[4 * g] * il, o0[4 * g + 1] * il); w0.y = pk2(o0[4 * g + 2] * il, o0[4 * g + 3] * il);
        w1.x = pk2(o1[4 * g] * il, o1[4 * g + 1] * il); w1.y = pk2(o1[4 * g + 2] * il, o1[4 * g + 3] * il);
        *(v2u*)(orow + 8 * g + 4 * hi) = w0; *(v2u*)(orow + 32 + 8 * g + 4 * hi) = w1; }
}
__device__ __forceinline__ void phase_attn(const Params& P, LAS unsigned char* lds, const int wv) {
    const int G = gridDim.x, bx = blockIdx.x, vcu = (G % 8 == 0) ? (bx % 8) * (G / 8) + bx / 8 : bx;
    for (int c = vcu; c < 256; c += G) { const int bh = c >> 3, s = c & 7; attn_unit(P, lds, bh, 15 - s, wv); attn_unit(P, lds, bh, s, wv); }
}

constexpr int HG_RS = 272, HG_KT_RS = 144;
__device__ __forceinline__ void hgrn_local_phase(const Params& P, LAS unsigned char* lds, const int wv) {
    const int tid = TIDX(wv), lane = tid & 63, j = tid >> 7, k = tid & 127, q32 = lane & 31, hi = lane >> 5, i16 = lane & 15, g16 = (lane >> 4) & 1;
    const float* LOGF = (const float*)(P.ws + WS_LOGF); const bf16* HI = (const bf16*)(P.ws + WS_HI);
    LAS unsigned char* KT = lds; LAS unsigned char* VS = lds + 18432; LAS float* TOT = (LAS float*)(lds + 18432 + 17408);
    float g[16]; v4u v0, v1;
#define HL_LOAD(u_) do { const int bh_ = (u_) >> 6, c_ = (u_) & 63; const size_t m0_ = (size_t)(bh_ >> 2) * SEQ + c_ * 64; const int h_ = bh_ & 3; \
        _Pragma("unroll") for (int i = 0; i < 16; ++i) g[i] = LOGF[(m0_ + 16 * j + i) * 512 + h_ * 128 + k]; \
        v0 = *(const v4u*)(HI + (m0_ + (tid >> 4)) * 512 + h_ * 128 + (tid & 15) * 8); v1 = *(const v4u*)(HI + (m0_ + 32 + (tid >> 4)) * 512 + h_ * 128 + (tid & 15) * 8); } while (0)
    int unit = blockIdx.x;
    if (unit < 1024) HL_LOAD(unit);
    for (; unit < 1024; unit += gridDim.x) {
    LDS_BAR();
    *(LAS v4u*)(VS + (tid >> 4) * HG_RS + (tid & 15) * 16) = v0; *(LAS v4u*)(VS + (32 + (tid >> 4)) * HG_RS + (tid & 15) * 16) = v1;
    float cs[16]; float run = 0.f;
#pragma unroll
    for (int i = 0; i < 16; ++i) { run += g[i]; cs[i] = run; }
    TOT[j * 128 + k] = run;
    LDS_BAR();
    const float t0 = TOT[k], t1 = TOT[128 + k], t2 = TOT[256 + k], t3 = TOT[384 + k];
    const float pre = (j > 0 ? t0 : 0.f) + (j > 1 ? t1 : 0.f) + (j > 2 ? t2 : 0.f), last = (t0 + t1) + (t2 + t3);
    { v4u w0, w1;
#pragma unroll
      for (int i = 0; i < 8; ++i) { const float a = (1.0f - __expf(g[2 * i])) * __expf(last - (pre + cs[2 * i])), bq = (1.0f - __expf(g[2 * i + 1])) * __expf(last - (pre + cs[2 * i + 1]));
          if (i < 4) w0[i] = pk2(a, bq); else w1[i - 4] = pk2(a, bq); }
      *(LAS v4u*)(KT + k * HG_KT_RS + j * 32) = w0; *(LAS v4u*)(KT + k * HG_KT_RS + j * 32 + 16) = w1; }
    if (j == 0) ((float*)(P.ws + WS_DEC))[(size_t)unit * 128 + k] = __expf(last);
    LDS_BAR();
    if (unit + (int)gridDim.x < 1024) HL_LOAD(unit + (int)gridDim.x);
    const int kb = wv >> 1, vb0 = 2 * (wv & 1);
    f32x16_t a0, a1;
#pragma unroll
    for (int r = 0; r < 16; ++r) { a0[r] = 0.f; a1[r] = 0.f; }
#pragma unroll
    for (int ks = 0; ks < 4; ++ks) {
        const bf16x8_t A = *(const LAS bf16x8_t*)(KT + (32 * kb + q32) * HG_KT_RS + (16 * ks + 8 * hi) * 2);
        const LAS unsigned char* vp = VS + (16 * ks + 8 * hi + (i16 >> 2)) * HG_RS + (32 * vb0 + 16 * g16 + 4 * (i16 & 3)) * 2;
        { const s16x4_t lo = vtr(vp), h4 = vtr(vp + 4 * HG_RS); a0 = __builtin_amdgcn_mfma_f32_32x32x16_bf16(A, __builtin_shufflevector(lo, h4, 0, 1, 2, 3, 4, 5, 6, 7), a0, 0, 0, 0); }
        { const s16x4_t lo = vtr(vp + 64), h4 = vtr(vp + 64 + 4 * HG_RS); a1 = __builtin_amdgcn_mfma_f32_32x32x16_bf16(A, __builtin_shufflevector(lo, h4, 0, 1, 2, 3, 4, 5, 6, 7), a1, 0, 0, 0); }
    }
    bf16* U = (bf16*)((unsigned char*)P.out + DO_ST) + (size_t)unit * 16384;
#pragma unroll
    for (int r = 0; r < 16; ++r) { const int kr = 32 * kb + crow(r, hi); U[kr * 128 + 32 * vb0 + q32] = (bf16)f2bf(a0[r]); U[kr * 128 + 32 * vb0 + 32 + q32] = (bf16)f2bf(a1[r]); }
    }
#undef HL_LOAD
}
__device__ __forceinline__ void hgrn_scan(const Params& P, const int wv) {
    const int tid = TIDX(wv);
    for (int e = blockIdx.x * 512 + tid; e < 131072; e += gridDim.x * 512) {
        const int bh = e >> 13, k = (e >> 6) & 127, vp = e & 63;
        unsigned* base = (unsigned*)((unsigned char*)P.out + DO_ST) + ((size_t)(bh * 64) * 128 + k) * 64 + vp;
        const float* dec = (const float*)(P.ws + WS_DEC) + (size_t)(bh * 64) * 128 + k;
        float s0 = 0.f, s1 = 0.f;
#pragma unroll 8
        for (int c = 0; c < 64; ++c) { const unsigned u = base[(size_t)c * 8192]; const float d = dec[c * 128];
            base[(size_t)c * 8192] = pk2(s0, s1); s0 = d * s0 + __uint_as_float(u << 16); s1 = d * s1 + __uint_as_float(u & 0xffff0000u); }
    }
}
__device__ __forceinline__ void hgrn_out_phase(const Params& P, LAS unsigned char* lds, const int wv) {
    const int tid = TIDX(wv), lane = tid & 63, j = tid >> 7, k = tid & 127, q32 = lane & 31, hi = lane >> 5, i16 = lane & 15, g16 = (lane >> 4) & 1;
    const float* LOGF = (const float*)(P.ws + WS_LOGF); const bf16* HQ = (const bf16*)(P.ws + WS_HQ); const bf16* HI = (const bf16*)(P.ws + WS_HI); const bf16* SG = (const bf16*)(P.ws + WS_SG);
    bf16* REC = (bf16*)(P.ws + WS_REC);
    LAS unsigned char* QT = lds; LAS unsigned char* QA = lds + 17408; LAS unsigned char* KB = lds + 34816; LAS unsigned char* VS = lds + 52224; LAS unsigned char* STL = lds + 69632;
    LAS float* TOT = (LAS float*)(lds + 104448); LAS float* XN = (LAS float*)(lds + 106496);
    float g[16]; bf16 qr[16]; v4u v0, v1, s4[4];
#define HG_LOAD(u_) do { const int bh_ = (u_) >> 6, c_ = (u_) & 63; const size_t m0_ = (size_t)(bh_ >> 2) * SEQ + c_ * 64; const int h_ = bh_ & 3; \
        const bf16* ST_ = (const bf16*)((unsigned char*)P.out + DO_ST) + (size_t)(u_) * 16384; \
        _Pragma("unroll") for (int i = 0; i < 16; ++i) { const size_t gi = (m0_ + 16 * j + i) * 512 + h_ * 128 + k; g[i] = LOGF[gi]; qr[i] = HQ[gi]; } \
        v0 = *(const v4u*)(HI + (m0_ + (tid >> 4)) * 512 + h_ * 128 + (tid & 15) * 8); v1 = *(const v4u*)(HI + (m0_ + 32 + (tid >> 4)) * 512 + h_ * 128 + (tid & 15) * 8); \
        _Pragma("unroll") for (int i = 0; i < 4; ++i) s4[i] = *(const v4u*)(ST_ + (size_t)((tid >> 4) + 32 * i) * 128 + (tid & 15) * 8); } while (0)
    int unit = blockIdx.x;
    if (unit < 1024) HG_LOAD(unit);
    for (; unit < 1024; unit += gridDim.x) {
    const int bh = unit >> 6, c = unit & 63, b = bh >> 2, h = bh & 3;
    const size_t m0 = (size_t)b * SEQ + c * 64;
    LDS_BAR();
    *(LAS v4u*)(VS + (tid >> 4) * HG_RS + (tid & 15) * 16) = v0; *(LAS v4u*)(VS + (32 + (tid >> 4)) * HG_RS + (tid & 15) * 16) = v1;
#pragma unroll
    for (int i = 0; i < 4; ++i) *(LAS v4u*)(STL + ((tid >> 4) + 32 * i) * HG_RS + (tid & 15) * 16) = s4[i];
    float cs[16]; float run = 0.f;
#pragma unroll
    for (int i = 0; i < 16; ++i) { run += g[i]; cs[i] = run; }
    TOT[j * 128 + k] = run;
    LDS_BAR();
    const float t0 = TOT[k], t1 = TOT[128 + k], t2 = TOT[256 + k];
    const float pre = (j > 0 ? t0 : 0.f) + (j > 1 ? t1 : 0.f) + (j > 2 ? t2 : 0.f), ref = t0 + t1;
#pragma unroll
    for (int i = 0; i < 16; ++i) { const int t = 16 * j + i; const float cum = pre + cs[i], kk = 1.0f - __expf(g[i]); const float qi = bf2f(qr[i]);
        *(LAS bf16*)(QT + t * HG_RS + k * 2) = (bf16)f2bf(qi * __expf(cum));
        *(LAS bf16*)(QA + t * HG_RS + k * 2) = (bf16)f2bf(qi * __expf(fminf(cum - ref, 80.f)));
        *(LAS bf16*)(KB + t * HG_RS + k * 2) = (bf16)f2bf(kk * __expf(fminf(ref - cum, 80.f))); }
    LDS_BAR();
    if (unit + (int)gridDim.x < 1024) HG_LOAD(unit + (int)gridDim.x);
    const int tb = wv >> 2, vb = wv & 3;
    f32x16_t att[2];
#pragma unroll
    for (int sb = 0; sb < 2; ++sb) {
#pragma unroll
        for (int r = 0; r < 16; ++r) att[sb][r] = 0.f;
        if (sb <= tb) {
#pragma unroll
            for (int ks = 0; ks < 8; ++ks) {
                const bf16x8_t A = *(const LAS bf16x8_t*)(KB + (32 * sb + q32) * HG_RS + (16 * ks + 8 * hi) * 2);
                const bf16x8_t Bq = *(const LAS bf16x8_t*)(QA + (32 * tb + q32) * HG_RS + (16 * ks + 8 * hi) * 2);
                att[sb] = __builtin_amdgcn_mfma_f32_32x32x16_bf16(A, Bq, att[sb], 0, 0, 0);
            }
            if (sb == tb) {
#pragma unroll
                for (int r = 0; r < 16; ++r) if (crow(r, hi) > q32) att[sb][r] = 0.f;
            }
        }
    }
    f32x16_t o;
#pragma unroll
    for (int r = 0; r < 16; ++r) o[r] = 0.f;
#pragma unroll
    for (int ks = 0; ks < 8; ++ks) {
        const LAS unsigned char* sp = STL + (16 * ks + 8 * hi + (i16 >> 2)) * HG_RS + (32 * vb + 16 * g16 + 4 * (i16 & 3)) * 2;
        const s16x4_t lo = vtr(sp), h4 = vtr(sp + 4 * HG_RS);
        const bf16x8_t Bq = *(const LAS bf16x8_t*)(QT + (32 * tb + q32) * HG_RS + (16 * ks + 8 * hi) * 2);
        o = __builtin_amdgcn_mfma_f32_32x32x16_bf16(__builtin_shufflevector(lo, h4, 0, 1, 2, 3, 4, 5, 6, 7), Bq, o, 0, 0, 0);
    }
#pragma unroll
    for (int sb = 0; sb < 2; ++sb) {
        if (sb <= tb) {
#pragma unroll
            for (int k2 = 0; k2 < 2; ++k2) {
                v4u w;
#pragma unroll
                for (int jj = 0; jj < 4; ++jj) w[jj] = pk2(att[sb][8 * k2 + 2 * jj], att[sb][8 * k2 + 2 * jj + 1]);
                const LAS unsigned char* vp = VS + (32 * sb + 16 * k2 + 4 * hi + (i16 >> 2)) * HG_RS + (32 * vb + 16 * g16 + 4 * (i16 & 3)) * 2;
                const s16x4_t lo = vtr(vp), h4 = vtr(vp + 8 * HG_RS);
                o = __builtin_amdgcn_mfma_f32_32x32x16_bf16(__builtin_shufflevector(lo, h4, 0, 1, 2, 3, 4, 5, 6, 7), __builtin_bit_cast(bf16x8_t, w), o, 0, 0, 0);
            }
        }
    }
    float ss = 0.f;
#pragma unroll
    for (int r = 0; r < 16; ++r) ss += o[r] * o[r];
    ss += __shfl_xor(ss, 32);
    if (hi == 0) XN[(32 * tb + q32) * 4 + vb] = ss;
    LDS_BAR();
    const f32x4 xs = *(const LAS f32x4*)(XN + (32 * tb + q32) * 4);
    const float rn = 1.0f / sqrtf(((xs[0] + xs[1]) + (xs[2] + xs[3])) * (1.0f / 128.0f) + EPS);
    const size_t ro = (m0 + 32 * tb + q32) * 512 + h * 128;
#pragma unroll
    for (int g4 = 0; g4 < 4; ++g4) { const int vv = 32 * vb + 8 * g4 + 4 * hi;
        const f32x4 gn = *(const f32x4*)(P.hgo_g + vv); const v2u sg = *(const v2u*)(SG + ro + vv);
        v2u w; w.x = pk2(o[4 * g4] * rn * gn[0] * __uint_as_float(sg.x << 16), o[4 * g4 + 1] * rn * gn[1] * __uint_as_float(sg.x & 0xffff0000u));
        w.y = pk2(o[4 * g4 + 2] * rn * gn[2] * __uint_as_float(sg.y << 16), o[4 * g4 + 3] * rn * gn[3] * __uint_as_float(sg.y & 0xffff0000u));
        *(v2u*)(REC + ro + vv) = w; }
    }
#undef HG_LOAD
}

__device__ __forceinline__ void grid_bar(unsigned* ctr, unsigned target, int tid) {
    asm volatile("s_waitcnt vmcnt(0) lgkmcnt(0)" ::: "memory");
    __syncthreads();
    if (tid == 0) {
        __builtin_amdgcn_fence(__ATOMIC_RELEASE, "agent");
        asm volatile("s_waitcnt vmcnt(0)" ::: "memory");
        __hip_atomic_fetch_add(ctr, 1u, __ATOMIC_RELAXED, __HIP_MEMORY_SCOPE_AGENT);
        unsigned spins = 0;
        while (__hip_atomic_load(ctr, __ATOMIC_RELAXED, __HIP_MEMORY_SCOPE_AGENT) < target) { __builtin_amdgcn_s_sleep(2); if (++spins > (1u << 26)) break; }
        __builtin_amdgcn_fence(__ATOMIC_ACQUIRE, "agent");
        asm volatile("s_waitcnt vmcnt(0)" ::: "memory");
    }
    __syncthreads();
}

#define XB_TMO      128
#define XB_XCNT(j)  (256  + 64 * (j))
#define XB_XSUB(j)  (1280 + 64 * (j))
#define XB_XGEN(j)  (2304 + 64 * (j))
#define XB_TOP      3328
#define XB_TOPGEN   3392
#define XCD_BAR_WORDS 3456
#define XB_SPIN_CAP (1u << 18)

__device__ __forceinline__ unsigned xb_ld(unsigned* p)              { return __hip_atomic_load(p, __ATOMIC_RELAXED, __HIP_MEMORY_SCOPE_AGENT); }
__device__ __forceinline__ unsigned xb_add(unsigned* p, unsigned v) { return __hip_atomic_fetch_add(p, v, __ATOMIC_RELAXED, __HIP_MEMORY_SCOPE_AGENT); }
__device__ __forceinline__ unsigned xb_xcc_id() { return (unsigned)__builtin_amdgcn_s_getreg((3 << 11) | 20) & 0xFu; }
#define XB_SPIN(cond, bar) do { unsigned _sp = 0; while (cond) { __builtin_amdgcn_s_sleep(1); \
    if ((++_sp & 255u) == 0u) { if (xb_ld(&(bar)[XB_TMO])) break; if (_sp > XB_SPIN_CAP) { atomicAdd(&(bar)[XB_TMO], 1u); break; } } } } while (0)

struct XcdBarrier {
    unsigned* bar; unsigned x;
    volatile LAS unsigned* st;
};

__device__ __forceinline__ XcdBarrier xcd_barrier_post(unsigned* bar, volatile LAS unsigned* st, int tid) {
    XcdBarrier b; b.bar = bar; b.x = xb_xcc_id(); b.st = st;
    if (tid == 0) (void)xb_add(&bar[XB_XCNT(b.x)], 1u);
    return b;
}
__device__ __forceinline__ void xcd_barrier_complete(unsigned* bar, unsigned x, unsigned& nloc, unsigned& nx) {
    const unsigned G = gridDim.x * gridDim.y * gridDim.z;
    unsigned sum, cnt, mine, sp = 0u;
    for (;;) {
        sum = 0u; cnt = 0u; mine = 0u;
#pragma unroll
        for (unsigned j = 0; j < 16; ++j) { const unsigned c = xb_ld(&bar[XB_XCNT(j)]); sum += c; cnt += (c > 0u) ? 1u : 0u; mine = (j == x) ? c : mine; }
        if (sum == G) break;
        __builtin_amdgcn_s_sleep(1);
        if ((++sp & 255u) == 0u) { if (xb_ld(&bar[XB_TMO])) break; if (sp > XB_SPIN_CAP) { atomicAdd(&bar[XB_TMO], 1u); break; } }
    }
    nloc = mine > 0u ? mine : 1u; nx = cnt > 0u ? cnt : 1u;
}

__device__ __forceinline__ void xcd_barrier(const XcdBarrier& b, int tid) {
    asm volatile("s_waitcnt vmcnt(0)" ::: "memory");
    __syncthreads();
    if (tid == 0) {
        unsigned* bar = b.bar;
        __builtin_amdgcn_s_waitcnt(0);
        unsigned nloc = b.st[0], nx = b.st[1];
        if (nloc == 0u) { xcd_barrier_complete(bar, b.x, nloc, nx); b.st[0] = nloc; b.st[1] = nx; }
        const unsigned old = xb_add(&bar[XB_XSUB(b.x)], 1u);
        const unsigned gen = old / nloc;
        if (old + 1u == (gen + 1u) * nloc) {
            __builtin_amdgcn_fence(__ATOMIC_RELEASE, "agent");
            asm volatile("s_waitcnt vmcnt(0)" ::: "memory");
            const unsigned og = xb_add(&bar[XB_TOP], 1u);
            const unsigned tg = og / nx;
            if (og + 1u == (tg + 1u) * nx) xb_add(&bar[XB_TOPGEN], 1u);
            else XB_SPIN(xb_ld(&bar[XB_TOPGEN]) == tg, bar);
            __builtin_amdgcn_fence(__ATOMIC_ACQUIRE, "agent");
            xb_add(&bar[XB_XGEN(b.x)], 1u);
            asm volatile("s_waitcnt vmcnt(0)" ::: "memory");
        } else {
            XB_SPIN(xb_ld(&bar[XB_XGEN(b.x)]) == gen, bar);
            __builtin_amdgcn_fence(__ATOMIC_ACQUIRE, "agent");
            asm volatile("s_waitcnt vmcnt(0)" ::: "memory");
        }
    }
    __syncthreads();
}

constexpr int NPHASE = 10;
#ifndef PROBE_DUP
#define PROBE_DUP 0
#endif
#define DUPK(k, ...) { __VA_ARGS__ } if constexpr (((PROBE_DUP >> (k)) & 1) != 0) { __syncthreads(); __VA_ARGS__ }
__global__ void __launch_bounds__(512, 2) fwd(Params P) {
    extern __shared__ __attribute__((aligned(16))) unsigned char lds_raw[];
    LAS unsigned char* lds = (LAS unsigned char*)lds_raw;
    cg::grid_group grid = cg::this_grid();
    const int wv = __builtin_amdgcn_readfirstlane(threadIdx.x >> 6);
    if (P.ph_lo < 0) grid.sync();
    unsigned char* ws = P.ws; unsigned char* dob = (unsigned char*)P.out;
    const int lo = P.ph_lo, hi = P.ph_hi;
    volatile LAS unsigned* xst = (volatile LAS unsigned*)(lds + 139264);
    if (TIDX(wv) < 2) xst[TIDX(wv)] = 0u;
    __syncthreads();
    const XcdBarrier xbar = xcd_barrier_post((unsigned*)(ws + WS_CTL), xst, TIDX(wv));
#define IN(k) (lo <= (k) && (k) < hi)
#define SEAM(k) do { if (IN(k) && IN((k) + 1)) { xcd_barrier(xbar, TIDX(wv)); if constexpr (((PROBE_DUP >> 10) & 1) != 0) xcd_barrier(xbar, TIDX(wv)); } } while (0)
    bf16* H = (bf16*)(ws + WS_H);
    if (IN(0)) { DUPK(0, phase_prep(P, lds, wv);) } SEAM(0);
    if (IN(1)) { DUPK(1,
        pg8::Gemm g{H, (const bf16*)(ws + WS_WIN), T, 2816, 1024}; pg8::StaticOrder S; S.init(T, 2816, gridDim.x, blockIdx.x);
        pg8::EpiInProj E{(bf16*)(dob + DO_CQ), (bf16*)(dob + DO_CKV), (bf16*)(ws + WS_HQ), (bf16*)(ws + WS_HI), (bf16*)(ws + WS_SG), (float*)(ws + WS_KR), (float*)(ws + WS_LOGF), (float*)(ws + WS_SSQ), P.lbl};
        pg8::gemm_phase<pg8::EpiInProj, pg8::StaticOrder, true, true>(lds, g, S, E, wv);
        __syncthreads();
        prep_late_weights(P, lds, wv, 192 * (int)gridDim.x / 256);
    ) } SEAM(1);
    if (IN(2)) { DUPK(2,
        PG8_LAS float* X = (PG8_LAS float*)(lds + 131072);
        { pg8::Gemm g{(const bf16*)(dob + DO_CKV), (const bf16*)(ws + WS_WUKV), T, 1024, 256}; pg8::StaticOrder S; S.init(T, 1024, gridDim.x, blockIdx.x);
          pg8::EpiKV E{(bf16*)(ws + WS_K), (bf16*)(ws + WS_V), (const float*)(ws + WS_SSQ), (const float*)(ws + WS_TAB), (const float*)(ws + WS_KR), P.kn_g, X};
          pg8::gemm_phase<pg8::EpiKV, pg8::StaticOrder, true, true>(lds, g, S, E, wv); }
        __syncthreads();
        { pg8::Gemm g{(const bf16*)(dob + DO_CQ), (const bf16*)(ws + WS_WUQ), T, 1024, 384}; pg8::StaticOrder S; S.init(T, 1024, gridDim.x, blockIdx.x);
          pg8::EpiQ E{(bf16*)(ws + WS_Q), (const float*)(ws + WS_SSQ), (const float*)(ws + WS_TAB), P.qn_g, X};
          pg8::gemm_phase<pg8::EpiQ, pg8::StaticOrder, true, true>(lds, g, S, E, wv); }
        __syncthreads();
        hgrn_local_phase(P, lds, wv);
        if constexpr (((PROBE_DUP >> 12) & 1) != 0) { __syncthreads(); hgrn_local_phase(P, lds, wv); }
    ) } SEAM(2);
    if (IN(3)) { hgrn_scan(P, wv); __syncthreads(); DUPK(3, phase_attn(P, lds, wv);) } SEAM(3);
    if (IN(4)) { DUPK(4,
        hgrn_out_phase(P, lds, wv);
        if constexpr (((PROBE_DUP >> 11) & 1) != 0) { __syncthreads(); hgrn_out_phase(P, lds, wv); }
        __syncthreads();
        pg8::Gemm g{H, (const bf16*)(ws + WS_WIN) + (size_t)2816 * 1024, T, 2048, 1024}; pg8::StaticOrder S; S.init(T, 2048, gridDim.x, blockIdx.x);
        pg8::EpiSigmoid E{(bf16*)(ws + WS_GATES), 2048};
        pg8::gemm_phase<pg8::EpiSigmoid, pg8::StaticOrder, true, true>(lds, g, S, E, wv);
    ) } SEAM(4);
    if (IN(5)) { DUPK(5,
        pg8::Gemm g{(const bf16*)(ws + WS_ATT), (const bf16*)(ws + WS_WBA), T, 1024, 512, (const bf16*)(ws + WS_REC), (const bf16*)(ws + WS_WBB)}; pg8::DualOrder S; S.init(T, 1024, gridDim.x, blockIdx.x);
        pg8::EpiGate2 E{H, (const bf16*)(ws + WS_GATES)};
        pg8::gemm_phase<pg8::EpiGate2, pg8::DualOrder, true, true>(lds, g, S, E, wv);
    ) } SEAM(5);
    if (IN(6)) { DUPK(6,
        pg8::Gemm g{H, (const bf16*)(ws + WS_WOUT), T, 1024, 1024}; pg8::StaticOrder S; S.init(T, 1024, gridDim.x, blockIdx.x);
        pg8::EpiResidX E{P.x, (bf16*)(ws + WS_LOGF), (float*)(ws + WS_SS1)};
        pg8::gemm_phase<pg8::EpiResidX, pg8::StaticOrder, true, true>(lds, g, S, E, wv);
    ) } SEAM(6);
    if (IN(7)) { DUPK(7,
        pg8::Gemm g{(const bf16*)(ws + WS_LOGF), (const bf16*)(ws + WS_WGU), T, 5632, 1024}; pg8::StaticOrder S; S.init(T, 5632, gridDim.x, blockIdx.x);
        pg8::EpiSwiGLU E{(bf16*)(ws + WS_ACT), (const float*)(ws + WS_SS1)};
        pg8::gemm_phase<pg8::EpiSwiGLU, pg8::StaticOrder, true, true>(lds, g, S, E, wv);
        __syncthreads();
        { pg8::Gemm g2{(const bf16*)(ws + WS_PB), (const bf16*)(ws + WS_WPP), T, 1024, 256}; pg8::SubOrder S2; S2.init(T, 1024, gridDim.x, blockIdx.x, (int)gridDim.x / 2);
          pg8::EpiPE E2{(bf16*)(ws + WS_ATT), (float*)(ws + WS_SSP)};
          pg8::gemm_phase<pg8::EpiPE, pg8::SubOrder, true, true>(lds, g2, S2, E2, wv); }
        __syncthreads();
        prep_wd(P, lds, wv, (int)gridDim.x / 2);
    ) } SEAM(7);
    if (IN(8)) {
        pg8::Gemm g{(const bf16*)(ws + WS_ACT), (const bf16*)(ws + WS_WD), T, 1024, 2816}; pg8::StaticOrder S; S.init(T, 1024, gridDim.x, blockIdx.x);
        pg8::EpiResidB E{(const bf16*)(ws + WS_LOGF), H, (float*)(ws + WS_SS2)};
        pg8::gemm_phase<pg8::EpiResidB, pg8::StaticOrder, true, true>(lds, g, S, E, wv);
    } SEAM(8);
    if (IN(9)) {
        pg8::Gemm g{H, (const bf16*)(ws + WS_WPG), T, 1024, 1024}; pg8::StaticOrder S; S.init(T, 1024, gridDim.x, blockIdx.x);
        pg8::EpiFinal E{P.out, H, (const bf16*)(ws + WS_ATT), (const float*)(ws + WS_SS2), (const float*)(ws + WS_SSP), P.pp_g};
        pg8::gemm_phase<pg8::EpiFinal, pg8::StaticOrder, true, true>(lds, g, S, E, wv);
    }
#undef IN
#undef SEAM
}

extern "C" void kernel_launch(void* const* d_in, const int* in_sizes, int n_in, void* d_out, int out_size, void* d_ws, size_t ws_size, hipStream_t stream) {
    static int grid = 0;
    if (!grid) {
        if (hipFuncSetAttribute((const void*)fwd, hipFuncAttributeMaxDynamicSharedMemorySize, LDS_BYTES) != hipSuccess) fprintf(stderr, "kernel_launch: hipFuncSetAttribute failed\n");
        int dev = 0, cus = 0;
        if (hipGetDevice(&dev) != hipSuccess || hipDeviceGetAttribute(&cus, hipDeviceAttributeMultiprocessorCount, dev) != hipSuccess || cus <= 0) cus = 256;
        (void)hipGetLastError();
        grid = cus;
    }
    Params P{};
    P.x = (const float*)d_in[0]; P.p = (const float*)d_in[1]; P.pos = (const int*)d_in[2];
    P.mix_g = (const float*)d_in[3]; P.w_in = (const float*)d_in[4]; P.qa_g = (const float*)d_in[5]; P.w_uq = (const float*)d_in[6]; P.kva_g = (const float*)d_in[7]; P.w_ukv = (const float*)d_in[8];
    P.qn_g = (const float*)d_in[9]; P.kn_g = (const float*)d_in[10]; P.lbl = (const float*)d_in[11]; P.hgo_g = (const float*)d_in[12]; P.w_br = (const float*)d_in[13]; P.w_out = (const float*)d_in[14];
    P.ffn_g = (const float*)d_in[15]; P.w_fg = (const float*)d_in[16]; P.w_fu = (const float*)d_in[17]; P.w_fd = (const float*)d_in[18]; P.pg_g = (const float*)d_in[19]; P.w_pg = (const float*)d_in[20];
    P.w_pp = (const float*)d_in[21]; P.pp_g = (const float*)d_in[22];
    P.out = (float*)d_out; P.ws = (unsigned char*)d_ws;
    P.ph_lo = 0; P.ph_hi = NPHASE;
    (void)hipMemsetAsync((unsigned char*)d_ws + WS_CTL, 0, 16384, stream);
    void* args[] = {&P};
    hipError_t e = hipLaunchCooperativeKernel((const void*)fwd, dim3(grid), dim3(512), args, LDS_BYTES, stream);
    if (e != hipSuccess) fprintf(stderr, "cooperative launch failed: %s (grid %d)\n", hipGetErrorString(e), grid);
}
```

```cpp
#include <hip/hip_runtime.h>
#include <hip/hip_cooperative_groups.h>
#include <cstdio>
#include <cstdint>
namespace cg = cooperative_groups;
namespace pg8 {
#define PG8_LAS __attribute__((address_space(3)))
typedef unsigned short bf16_t;
typedef short bf16x8 __attribute__((ext_vector_type(8)));
typedef float f32x4 __attribute__((ext_vector_type(4)));
typedef unsigned u32x4 __attribute__((ext_vector_type(4)));
constexpr int BM = 256, BK = 64, HALF = 128, HTB = HALF * BK * 2  , STAGE_BYTES = 8 * HTB, NXCD = 8, WGM = 8;

__host__ __device__ __forceinline__ int lds_byte(int r, int c) { const int st = (r >> 4) * 2 + (c >> 5), rr = r & 15, cc = c & 31, ob = rr * 64 + cc * 2; return st * 1024 + (ob ^ (((ob >> 9) & 1) << 5)); }
__host__ __device__ __forceinline__ void stage_rc(int b, int& R, int& C) { const int st = b / 1024, sb = b % 1024, swz = sb ^ (((sb >> 9) & 1) << 5); R = (st >> 1) * 16 + swz / 64; C = (st & 1) * 32 + (swz % 64) / 2; }
__host__ __device__ __forceinline__ int perm32(int rho) { const int n = rho >> 4, i = rho & 15; return 8 * (i >> 2) + 4 * n + (i & 3); }

struct Unit { int pm, pn, kind = 0; };
struct Gemm { const bf16_t* A; const bf16_t* Bt; int M, N, K; const bf16_t* A1 = nullptr; const bf16_t* Bt1 = nullptr; };

struct StaticOrder {
    int nM, nN, nwg, G, c;
    __host__ __device__ void init(int M, int N, int G_, int c_) { nM = M / BM; nN = N / BM; nwg = nM * nN; G = G_; c = c_; }
    __host__ __device__ bool next(int i, Unit& u) const {
        const long L = (long)i * G + c; if (L >= nwg) return false;
        int wgid = (int)L; { const int q = nwg / NXCD, r = nwg % NXCD, xcd = wgid % NXCD, off = wgid / NXCD; wgid = (xcd < r ? xcd * (q + 1) : r * (q + 1) + (xcd - r) * q) + off; }
        const int nig = WGM * nN, gid = wgid / nig, fm = gid * WGM, gsz = (nM - fm) < WGM ? (nM - fm) : WGM;
        u.pm = fm + ((wgid % nig) % gsz); u.pn = (wgid % nig) / gsz; return true;
    }
    __device__ __forceinline__ void a_ready(const Unit&) const {}
    __device__ __forceinline__ void done(const Unit&) const {}
};


struct DualOrder {
    StaticOrder so;
    __host__ __device__ void init(int M, int N, int G_, int c_) { so.init(M, N, G_, c_); }
    __host__ __device__ bool next(int i, Unit& u) const { if (!so.next(i >> 1, u)) return false; u.kind = i & 1; return true; }
    __device__ __forceinline__ void a_ready(const Unit&) const {}
    __device__ __forceinline__ void done(const Unit&) const {}
};
struct SubOrder {
    int nN, nwg, first, nblk, c;
    __host__ __device__ void init(int M, int N, int G_, int c_, int first_) { nN = N / BM; nwg = (M / BM) * nN; first = first_; nblk = G_ - first_; c = c_; }
    __host__ __device__ bool next(int i, Unit& u) const { if (c < first) return false; const int L = i * nblk + (c - first); if (L >= nwg) return false; u.pm = L / nN; u.pn = L % nN; return true; }
    __device__ __forceinline__ void a_ready(const Unit&) const {}
    __device__ __forceinline__ void done(const Unit&) const {}
};
__device__ __forceinline__ unsigned cvt_pk_bf16(float lo, float hi) { unsigned r; asm volatile("v_cvt_pk_bf16_f32 %0, %1, %2" : "=v"(r) : "v"(lo), "v"(hi)); return r; }
constexpr float EPS_ = 1e-6f;
typedef float f32x2_t __attribute__((ext_vector_type(2))); typedef __bf16 bf16x2_t __attribute__((ext_vector_type(2)));
__device__ __forceinline__ unsigned cvtpk(float lo, float hi) { f32x2_t v = {lo, hi}; bf16x2_t b = __builtin_convertvector(v, bf16x2_t); return __builtin_bit_cast(unsigned, b); }
__device__ __forceinline__ u32x4 pack8(const f32x4 a, const f32x4 b) { u32x4 w; w.x = cvtpk(a[0], a[1]); w.y = cvtpk(a[2], a[3]); w.z = cvtpk(b[0], b[1]); w.w = cvtpk(b[2], b[3]); return w; }
__device__ __forceinline__ void unpack8(const u32x4 w, f32x4& a, f32x4& b) {
    a[0] = __uint_as_float(w.x << 16); a[1] = __uint_as_float(w.x & 0xffff0000u); a[2] = __uint_as_float(w.y << 16); a[3] = __uint_as_float(w.y & 0xffff0000u);
    b[0] = __uint_as_float(w.z << 16); b[1] = __uint_as_float(w.z & 0xffff0000u); b[2] = __uint_as_float(w.w << 16); b[3] = __uint_as_float(w.w & 0xffff0000u); }
__device__ __forceinline__ float sigm(float x) { return __builtin_amdgcn_rcpf(1.0f + __expf(-x)); }
__device__ __forceinline__ float sumsq8(const f32x4 a, const f32x4 b) { return (a[0] * a[0] + a[1] * a[1]) + (a[2] * a[2] + a[3] * a[3]) + (b[0] * b[0] + b[1] * b[1]) + (b[2] * b[2] + b[3] * b[3]); }
__device__ __forceinline__ float rowscale16(const float* ss, int row, float invn) {
    const f32x4* p = (const f32x4*)(ss + (size_t)row * 16); const f32x4 a = p[0], b = p[1], c = p[2], d = p[3];
    const float s = ((a[0] + a[1]) + (a[2] + a[3])) + ((b[0] + b[1]) + (b[2] + b[3])) + ((c[0] + c[1]) + (c[2] + c[3])) + ((d[0] + d[1]) + (d[2] + d[3]));
    return __builtin_amdgcn_rsqf(s * invn + EPS_); }
#define EPI_SIG const f32x4 (&acc)[2][2][4][2], const Unit& u, int wr, int wc, int fr, int fq
#define EPI_ROWS(ai, m) (u.pm * 256 + wr * 64 + fr + (ai) * 128 + (m) * 16)
#define EPI_FOR_ROWS _Pragma("unroll") for (int ai = 0; ai < 2; ++ai) _Pragma("unroll") for (int m = 0; m < 4; ++m)

struct EpiInProj {
    static constexpr bool PERM = true, AFTER_DRAIN = false, CHAIN = false;
    bf16_t *CQ, *CKV, *HQ, *HI, *SG; float *KR, *LOGF, *SSQ; const float* lbl;
    __device__ __forceinline__ void operator()(EPI_SIG) const {
        const int cw = wc * 32 + fq * 8;
#pragma unroll
        for (int bj = 0; bj < 2; ++bj) {
            const int hb = u.pn * 2 + bj;
            if (hb < 3 || hb == 4 || hb == 5) {
                bf16_t* dst; int ld, c0, slot;
                if (hb < 3) { dst = CQ; ld = 384; c0 = hb * 128 + cw; slot = hb * 4 + wc; } else { dst = CKV; ld = 256; c0 = (hb - 4) * 128 + cw; slot = 12 + (hb - 4) * 4 + wc; }
                EPI_FOR_ROWS { const int row = EPI_ROWS(ai, m); const f32x4 v0 = acc[ai][bj][m][0], v1 = acc[ai][bj][m][1];
                    float ss = sumsq8(v0, v1); ss += __shfl_xor(ss, 16); ss += __shfl_xor(ss, 32);
                    *(u32x4*)(dst + (size_t)row * ld + c0) = pack8(v0, v1);
                    if (fq == 0) SSQ[(size_t)row * 20 + slot] = ss; }
            } else if (hb == 3) {
                if (wc == 0) { EPI_FOR_ROWS { const int row = EPI_ROWS(ai, m); float* d = KR + (size_t)row * 32 + fq * 8; *(f32x4*)d = acc[ai][bj][m][0]; *(f32x4*)(d + 4) = acc[ai][bj][m][1]; } }
            } else if (hb < 10) {
                const int c0 = (hb - 6) * 128 + cw;
                EPI_FOR_ROWS { const int row = EPI_ROWS(ai, m); *(u32x4*)(HQ + (size_t)row * 512 + c0) = pack8(acc[ai][bj][m][0], acc[ai][bj][m][1]); }
            } else if (hb < 14) {
                const int c0 = (hb - 10) * 128 + cw;
                f32x4 lb[2];
#pragma unroll
                for (int n = 0; n < 2; ++n) { const f32x4 l0 = *(const f32x4*)(lbl + c0 + 4 * n), l1 = *(const f32x4*)(lbl + 512 + c0 + 4 * n);
#pragma unroll
                    for (int i = 0; i < 4; ++i) lb[n][i] = __builtin_amdgcn_rcpf(1.0f + __expf(l1[i] - l0[i])); }
                EPI_FOR_ROWS { const int row = EPI_ROWS(ai, m); f32x4 o[2];
#pragma unroll
                    for (int n = 0; n < 2; ++n)
#pragma unroll
                        for (int i = 0; i < 4; ++i) { const float f = lb[n][i] + (1.0f - lb[n][i]) * sigm(acc[ai][bj][m][n][i]); o[n][i] = __logf(f); }
                    float* d = LOGF + (size_t)row * 512 + c0; *(f32x4*)d = o[0]; *(f32x4*)(d + 4) = o[1]; }
            } else if (hb < 18) {
                const int c0 = (hb - 14) * 128 + cw;
                EPI_FOR_ROWS { const int row = EPI_ROWS(ai, m); *(u32x4*)(HI + (size_t)row * 512 + c0) = pack8(acc[ai][bj][m][0], acc[ai][bj][m][1]); }
            } else {
                const int c0 = (hb - 18) * 128 + cw;
                EPI_FOR_ROWS { const int row = EPI_ROWS(ai, m); f32x4 o[2];
#pragma unroll
                    for (int n = 0; n < 2; ++n)
#pragma unroll
                        for (int i = 0; i < 4; ++i) { const float v = acc[ai][bj][m][n][i]; o[n][i] = v * sigm(v); }
                    *(u32x4*)(SG + (size_t)row * 512 + c0) = pack8(o[0], o[1]); }
            }
        }
    }
};
struct EpiSigmoid {
    static constexpr bool PERM = true, AFTER_DRAIN = false, CHAIN = false;
    bf16_t* O; int ldc;
    __device__ __forceinline__ void operator()(EPI_SIG) const {
        const int cw = u.pn * 256 + wc * 32 + fq * 8;
        EPI_FOR_ROWS { const int row = EPI_ROWS(ai, m);
#pragma unroll
            for (int bj = 0; bj < 2; ++bj) { f32x4 o[2];
#pragma unroll
                for (int n = 0; n < 2; ++n)
#pragma unroll
                    for (int i = 0; i < 4; ++i) o[n][i] = sigm(acc[ai][bj][m][n][i]);
                *(u32x4*)(O + (size_t)row * ldc + cw + bj * 128) = pack8(o[0], o[1]); } }
    }
};
struct EpiGate2 {
    static constexpr bool PERM = true, AFTER_DRAIN = false, CHAIN = true;
    bf16_t* O; const bf16_t* G;
    __device__ __forceinline__ void chain(f32x4 (&acc)[2][2][4][2], const Unit& u, int wr, int wc, int fr, int fq) const {
        const int cw = u.pn * 256 + wc * 32 + fq * 8;
        EPI_FOR_ROWS { const int row = EPI_ROWS(ai, m);
#pragma unroll
            for (int bj = 0; bj < 2; ++bj) { const int col = cw + bj * 128;
                f32x4 a0, a1, b0, b1; unpack8(*(const u32x4*)(G + (size_t)row * 2048 + col), a0, a1); unpack8(*(const u32x4*)(G + (size_t)row * 2048 + 1024 + col), b0, b1);
#pragma unroll
                for (int i = 0; i < 4; ++i) { acc[ai][bj][m][0][i] *= a0[i] * __builtin_amdgcn_rcpf(fmaxf(b0[i], 1e-20f)); acc[ai][bj][m][1][i] *= a1[i] * __builtin_amdgcn_rcpf(fmaxf(b1[i], 1e-20f)); } } }
    }
    __device__ __forceinline__ void operator()(EPI_SIG) const {
        const int cw = u.pn * 256 + wc * 32 + fq * 8;
        EPI_FOR_ROWS { const int row = EPI_ROWS(ai, m);
#pragma unroll
            for (int bj = 0; bj < 2; ++bj) { const int col = cw + bj * 128;
                f32x4 b0, b1; unpack8(*(const u32x4*)(G + (size_t)row * 2048 + 1024 + col), b0, b1);
#pragma unroll
                for (int i = 0; i < 4; ++i) { b0[i] = fmaxf(b0[i], 1e-20f); b1[i] = fmaxf(b1[i], 1e-20f); }
                *(u32x4*)(O + (size_t)row * 1024 + col) = pack8(b0 * acc[ai][bj][m][0], b1 * acc[ai][bj][m][1]); } }
    }
};
struct EpiResidX {
    static constexpr bool PERM = true, AFTER_DRAIN = false, CHAIN = false;
    const float* base; bf16_t* outb; float* SS;
    __device__ __forceinline__ void operator()(EPI_SIG) const {
        const int cw = u.pn * 256 + wc * 32 + fq * 8;
        EPI_FOR_ROWS { const int row = EPI_ROWS(ai, m); float ss = 0.f;
#pragma unroll
            for (int bj = 0; bj < 2; ++bj) { const size_t off = (size_t)row * 1024 + cw + bj * 128;
                const f32x4 o0 = __builtin_nontemporal_load((const f32x4*)(base + off)) + acc[ai][bj][m][0], o1 = __builtin_nontemporal_load((const f32x4*)(base + off + 4)) + acc[ai][bj][m][1];
                *(u32x4*)(outb + off) = pack8(o0, o1); ss += sumsq8(o0, o1); }
            ss += __shfl_xor(ss, 16); ss += __shfl_xor(ss, 32);
            if (fq == 0) SS[(size_t)row * 16 + u.pn * 4 + wc] = ss; }
    }
};
struct EpiResidB {
    static constexpr bool PERM = true, AFTER_DRAIN = false, CHAIN = false;
    const bf16_t* base; bf16_t* outb; float* SS;
    __device__ __forceinline__ void operator()(EPI_SIG) const {
        const int cw = u.pn * 256 + wc * 32 + fq * 8;
        EPI_FOR_ROWS { const int row = EPI_ROWS(ai, m); float ss = 0.f;
#pragma unroll
            for (int bj = 0; bj < 2; ++bj) { const size_t off = (size_t)row * 1024 + cw + bj * 128;
                f32x4 b0, b1; unpack8(*(const u32x4*)(base + off), b0, b1);
                const f32x4 o0 = b0 + acc[ai][bj][m][0], o1 = b1 + acc[ai][bj][m][1];
                *(u32x4*)(outb + off) = pack8(o0, o1); ss += sumsq8(o0, o1); }
            ss += __shfl_xor(ss, 16); ss += __shfl_xor(ss, 32);
            if (fq == 0) SS[(size_t)row * 16 + u.pn * 4 + wc] = ss; }
    }
};
struct EpiSwiGLU {
    static constexpr bool PERM = true, AFTER_DRAIN = false, CHAIN = false;
    bf16_t* ACT; const float* SS;
    __device__ __forceinline__ void operator()(EPI_SIG) const {
        const int cw = u.pn * 128 + wc * 32 + fq * 8;
        EPI_FOR_ROWS { const int row = EPI_ROWS(ai, m); const float r = rowscale16(SS, row, 1.0f / 1024.0f), rl = r * -1.4426950408889634f, r2 = r * r; f32x4 o[2];
#pragma unroll
            for (int n = 0; n < 2; ++n)
#pragma unroll
                for (int i = 0; i < 4; ++i) { const float ag = acc[ai][0][m][n][i], au = acc[ai][1][m][n][i];
                    o[n][i] = (ag * au) * (r2 * __builtin_amdgcn_rcpf(1.0f + __builtin_amdgcn_exp2f(ag * rl))); }
            __builtin_nontemporal_store(pack8(o[0], o[1]), (u32x4*)(ACT + (size_t)row * 2816 + cw)); }
    }
};
struct EpiPE {
    static constexpr bool PERM = true, AFTER_DRAIN = false, CHAIN = false;
    bf16_t* PE; float* SS;
    __device__ __forceinline__ void operator()(EPI_SIG) const {
        const int cw = u.pn * 256 + wc * 32 + fq * 8;
        EPI_FOR_ROWS { const int row = EPI_ROWS(ai, m); float ss = 0.f;
#pragma unroll
            for (int bj = 0; bj < 2; ++bj) { *(u32x4*)(PE + (size_t)row * 1024 + cw + bj * 128) = pack8(acc[ai][bj][m][0], acc[ai][bj][m][1]); ss += sumsq8(acc[ai][bj][m][0], acc[ai][bj][m][1]); }
            ss += __shfl_xor(ss, 16); ss += __shfl_xor(ss, 32);
            if (fq == 0) SS[(size_t)row * 16 + u.pn * 4 + wc] = ss; }
    }
};
struct EpiFinal {
    static constexpr bool PERM = true, AFTER_DRAIN = false, CHAIN = false;
    float* out; const bf16_t* X2; const bf16_t* PE; const float *SS2, *SSP, *gpost;
    __device__ __forceinline__ void operator()(EPI_SIG) const {
        const int cw = u.pn * 256 + wc * 32 + fq * 8;
        EPI_FOR_ROWS { const int row = EPI_ROWS(ai, m); const float r2 = rowscale16(SS2, row, 1.0f / 1024.0f), re = rowscale16(SSP, row, 1.0f / 1024.0f);
#pragma unroll
            for (int bj = 0; bj < 2; ++bj) { const int col = cw + bj * 128; const size_t off = (size_t)row * 1024 + col;
                f32x4 e0, e1; unpack8(*(const u32x4*)(PE + off), e0, e1);
                f32x4 o0, o1; unpack8(*(const u32x4*)(X2 + off), o0, o1);
                const f32x4 g0 = *(const f32x4*)(gpost + col), g1 = *(const f32x4*)(gpost + col + 4);
#pragma unroll
                for (int i = 0; i < 4; ++i) { o0[i] += sigm(acc[ai][bj][m][0][i] * r2) * (e0[i] * re * g0[i]); o1[i] += sigm(acc[ai][bj][m][1][i] * r2) * (e1[i] * re * g1[i]); }
                __builtin_nontemporal_store(o0, (f32x4*)(out + off)); __builtin_nontemporal_store(o1, (f32x4*)(out + off + 4)); } }
    }
};

constexpr float QSCALE_ = 0.10206207261596577f * 1.4426950408889634f;
#define EPI_XBAR() do { asm volatile("s_waitcnt lgkmcnt(0)" ::: "memory"); __builtin_amdgcn_s_barrier(); asm volatile("" ::: "memory"); } while (0)
__device__ __forceinline__ float sum4(const f32x4 a) { return (a[0] + a[1]) + (a[2] + a[3]); }
typedef unsigned u32x2_ __attribute__((ext_vector_type(2)));
struct EpiQ {
    static constexpr bool PERM = true, AFTER_DRAIN = false, CHAIN = false;
    bf16_t* Q; const float *SSQ, *TAB, *g; PG8_LAS float* X;
    __device__ __forceinline__ void operator()(EPI_SIG) const {
        { int l_; asm volatile("v_mbcnt_lo_u32_b32 %0, -1, 0\n\tv_mbcnt_hi_u32_b32 %0, -1, %0" : "=v"(l_)); fr = l_ & 15; fq = l_ >> 4; }
        const int rt0 = wr * 64 + fr;
        EPI_FOR_ROWS { const int rt = rt0 + ai * 128 + m * 16;
#pragma unroll
            for (int bj = 0; bj < 2; ++bj) { float ss = sumsq8(acc[ai][bj][m][0], acc[ai][bj][m][1]); ss += __shfl_xor(ss, 16); ss += __shfl_xor(ss, 32); if (fq == 0) X[rt * 8 + bj * 4 + wc] = ss; } }
        EPI_XBAR();
        if (wc == 3) return;
        EPI_FOR_ROWS { const int row = EPI_ROWS(ai, m), rt = rt0 + ai * 128 + m * 16, b = row >> 12, s = row & 4095;
            const f32x4* sq = (const f32x4*)(SSQ + (size_t)row * 20);
            const float rq0 = __builtin_amdgcn_rsqf((sum4(sq[0]) + sum4(sq[1]) + sum4(sq[2])) * (1.0f / 384.0f) + EPS_);
#pragma unroll
            for (int bj = 0; bj < 2; ++bj) { const int head = 2 * u.pn + bj;
                const f32x4 xs = *(const PG8_LAS f32x4*)(X + rt * 8 + bj * 4);
                const float sc = __builtin_amdgcn_rsqf(sum4(xs) * rq0 * rq0 * (1.0f / 96.0f) + EPS_) * rq0 * QSCALE_;
                bf16_t* dst = Q + ((size_t)(b * 8 + head) * 4096 + s) * 96;
                if (wc < 2) { const int c = 32 * wc + 8 * fq; const f32x4 g0 = *(const f32x4*)(g + c), g1 = *(const f32x4*)(g + c + 4);
                    *(u32x4*)(dst + c) = pack8(acc[ai][bj][m][0] * sc * g0, acc[ai][bj][m][1] * sc * g1);
                } else { const int i0 = 4 * fq; const f32x4 g1 = *(const f32x4*)(g + 64 + i0), g2 = *(const f32x4*)(g + 80 + i0);
                    const f32x4 cs = *(const f32x4*)(TAB + (size_t)row * 32 + i0), sn = *(const f32x4*)(TAB + (size_t)row * 32 + 16 + i0);
                    const f32x4 x1 = acc[ai][bj][m][0] * sc * g1, x2 = acc[ai][bj][m][1] * sc * g2, o1 = x1 * cs - x2 * sn, o2 = x2 * cs + x1 * sn;
                    u32x2_ w1, w2; w1.x = cvtpk(o1[0], o1[1]); w1.y = cvtpk(o1[2], o1[3]); w2.x = cvtpk(o2[0], o2[1]); w2.y = cvtpk(o2[2], o2[3]);
                    *(u32x2_*)(dst + 64 + i0) = w1; *(u32x2_*)(dst + 80 + i0) = w2; }
            } asm volatile("" ::: "memory"); }
    }
};
struct EpiKV {
    static constexpr bool PERM = true, AFTER_DRAIN = false, CHAIN = false;
    bf16_t *K, *V; const float *SSQ, *TAB, *KR, *g; PG8_LAS float* X;
    __device__ __forceinline__ void operator()(EPI_SIG) const {
        { int l_; asm volatile("v_mbcnt_lo_u32_b32 %0, -1, 0\n\tv_mbcnt_hi_u32_b32 %0, -1, %0" : "=v"(l_)); fr = l_ & 15; fq = l_ >> 4; }
        const int rt0 = wr * 64 + fr;
        EPI_FOR_ROWS { const int rt = rt0 + ai * 128 + m * 16, row = EPI_ROWS(ai, m);
            if (wc < 2) {
#pragma unroll
                for (int bj = 0; bj < 2; ++bj) { float ss = sumsq8(acc[ai][bj][m][0], acc[ai][bj][m][1]); ss += __shfl_xor(ss, 16); ss += __shfl_xor(ss, 32); if (fq == 0) X[rt * 8 + bj * 4 + wc] = ss; }
            } else if (wc == 2) { const f32x4 a = *(const f32x4*)(KR + (size_t)row * 32 + 4 * fq), bq = *(const f32x4*)(KR + (size_t)row * 32 + 16 + 4 * fq);
                float ss = sumsq8(a, bq); ss += __shfl_xor(ss, 16); ss += __shfl_xor(ss, 32); if (fq == 0) X[rt * 8 + 3] = ss; }
            asm volatile("" ::: "memory");
        }
        EPI_XBAR();
        EPI_FOR_ROWS { const int row = EPI_ROWS(ai, m), rt = rt0 + ai * 128 + m * 16, b = row >> 12, s = row & 4095;
            const f32x4* sq = (const f32x4*)(SSQ + (size_t)row * 20 + 12);
            const float rkv = __builtin_amdgcn_rsqf((sum4(sq[0]) + sum4(sq[1])) * (1.0f / 256.0f) + EPS_);
            const f32x4 xa = *(const PG8_LAS f32x4*)(X + rt * 8), xb = *(const PG8_LAS f32x4*)(X + rt * 8 + 4);
#pragma unroll
            for (int bj = 0; bj < 2; ++bj) { const int head = 2 * u.pn + bj;
                const float nss = bj == 0 ? xa[0] + xa[1] : xb[0] + xb[1];
                const float rk = __builtin_amdgcn_rsqf((nss * rkv * rkv + xa[3]) * (1.0f / 96.0f) + EPS_);
                const size_t ri = (size_t)(b * 8 + head) * 4096 + s;
                if (wc < 2) { const int c = 32 * wc + 8 * fq; const f32x4 g0 = *(const f32x4*)(g + c), g1 = *(const f32x4*)(g + c + 4); const float sc = rkv * rk;
                    *(u32x4*)(K + ri * 96 + c) = pack8(acc[ai][bj][m][0] * sc * g0, acc[ai][bj][m][1] * sc * g1);
                } else { const int c = 32 * (wc - 2) + 8 * fq;
                    *(u32x4*)(V + ri * 64 + c) = pack8(acc[ai][bj][m][0] * rkv, acc[ai][bj][m][1] * rkv);
                    if (wc == 2) { const int i0 = 4 * fq; const f32x4 g1 = *(const f32x4*)(g + 64 + i0), g2 = *(const f32x4*)(g + 80 + i0);
                        const f32x4 cs = *(const f32x4*)(TAB + (size_t)row * 32 + i0), sn = *(const f32x4*)(TAB + (size_t)row * 32 + 16 + i0);
                        const f32x4 x1 = *(const f32x4*)(KR + (size_t)row * 32 + i0) * rk * g1, x2 = *(const f32x4*)(KR + (size_t)row * 32 + 16 + i0) * rk * g2, o1 = x1 * cs - x2 * sn, o2 = x2 * cs + x1 * sn;
                        u32x2_ w1, w2; w1.x = cvtpk(o1[0], o1[1]); w1.y = cvtpk(o1[2], o1[3]); w2.x = cvtpk(o2[0], o2[1]); w2.y = cvtpk(o2[2], o2[3]);
                        *(u32x2_*)(K + ri * 96 + 64 + i0) = w1; *(u32x2_*)(K + ri * 96 + 80 + i0) = w2; } }
            } asm volatile("" ::: "memory"); }
    }
};
template <class Epi, class Sched, bool ALIGN_EPI = false, bool SP2 = false>
__device__ __forceinline__ void gemm_phase(PG8_LAS unsigned char* lds, const Gemm g, const Sched& S, const Epi& E, const int wv_) {
    int tid_; asm volatile("v_mbcnt_lo_u32_b32 %0, -1, 0\n\tv_mbcnt_hi_u32_b32 %0, -1, %0" : "=v"(tid_)); tid_ += wv_ * 64;
    const int tid = tid_, wid = __builtin_amdgcn_readfirstlane(tid >> 6), lane = tid & 63, wr = wid >> 2, wc = wid & 3, fr = lane & 15, fq = lane >> 4;
    const int K = g.K, nt = K / BK;
    unsigned voffA[2], voffB[2];
#pragma unroll
    for (int i = 0; i < 2; ++i) { int R, C; stage_rc(tid * 16 + i * 8192, R, C); const int Rb = Epi::PERM ? ((R & ~31) + perm32(R & 31)) : R;
        voffA[i] = (unsigned)(R * K + C) * 2u; voffB[i] = (unsigned)(Rb * K + C) * 2u; }
    const size_t kstep = (size_t)(BK * 2);
    const size_t hstep = (size_t)HALF * K * 2;
    const size_t tstep = 2 * hstep;
    const unsigned ldsw = (unsigned)wid * 1024u;
    const int aoff = lds_byte(wr * 64 + fr, fq * 8), boff = lds_byte(wc * 32 + fr, fq * 8);
#define PG8_SA(b, h) (((b) * 2 + (h)) * HTB)
#define PG8_SB(b, h) ((4 + (b) * 2 + (h)) * HTB)
#define PG8_STAGE(bufoff, gbase, voff) do { _Pragma("unroll") for (int _i = 0; _i < 2; ++_i) \
        __builtin_amdgcn_global_load_lds((const unsigned*)((const char*)(gbase) + (voff)[_i]), (PG8_LAS unsigned*)(lds + (bufoff) + ldsw + _i * 8192), 16, 0, 0); } while (0)
#define PG8_LDA(dst, b, h) do { _Pragma("unroll") for (int m = 0; m < 4; ++m) _Pragma("unroll") for (int k = 0; k < 2; ++k) dst[m][k] = *(const PG8_LAS bf16x8*)(lds + PG8_SA(b, h) + aoff + m * 2048 + k * 1024); } while (0)
#define PG8_LDB(dst, b, h) do { _Pragma("unroll") for (int n = 0; n < 2; ++n) _Pragma("unroll") for (int k = 0; k < 2; ++k) dst[n][k] = *(const PG8_LAS bf16x8*)(lds + PG8_SB(b, h) + boff + n * 2048 + k * 1024); } while (0)
#define PG8_MMA(ai, bj, At, Bt) do { __builtin_amdgcn_s_setprio(1); _Pragma("unroll") for (int m = 0; m < 4; ++m) _Pragma("unroll") for (int n = 0; n < 2; ++n) _Pragma("unroll") for (int k = 0; k < 2; ++k) \
        acc[ai][bj][m][n] = __builtin_amdgcn_mfma_f32_16x16x32_bf16(Bt[n][k], At[m][k], acc[ai][bj][m][n], 0, 0, 0); __builtin_amdgcn_s_setprio(0); } while (0)
#define PG8_WAIT_V(n) asm volatile("s_waitcnt vmcnt(" #n ")" ::: "memory")
#define PG8_WAIT_L(n) asm volatile("s_waitcnt lgkmcnt(" #n ")" ::: "memory")
#define PG8_BAR __builtin_amdgcn_s_barrier()
#define PG8_SCHED __builtin_amdgcn_sched_barrier(0)
    Unit cur, nxt; int ui = 0;
    if (!S.next(0, cur)) return;
    f32x4 acc[2][2][4][2];
#pragma unroll
    for (int a = 0; a < 2; ++a)
#pragma unroll
        for (int b = 0; b < 2; ++b)
#pragma unroll
            for (int m = 0; m < 4; ++m)
#pragma unroll
                for (int n = 0; n < 2; ++n) acc[a][b][m][n] = (f32x4){0.f, 0.f, 0.f, 0.f};
    bf16x8 At[4][2], B0[2][2], B1[2][2];
    const char* cA = (const char*)(cur.kind ? g.A1 : g.A) + (size_t)cur.pm * tstep; const char* cB = (const char*)(cur.kind ? g.Bt1 : g.Bt) + (size_t)cur.pn * tstep;
    S.a_ready(cur);
    if constexpr (SP2) {
        PG8_STAGE(PG8_SB(0, 0), cB, voffB); PG8_STAGE(PG8_SB(0, 1), cB + hstep, voffB); PG8_STAGE(PG8_SA(0, 0), cA, voffA); PG8_STAGE(PG8_SA(0, 1), cA + hstep, voffA);
        if (wr == 1) PG8_BAR;
        PG8_WAIT_V(2); PG8_BAR;
        PG8_STAGE(PG8_SB(1, 0), cB + kstep, voffB); PG8_STAGE(PG8_SA(1, 0), cA + kstep, voffA); PG8_STAGE(PG8_SB(1, 1), cB + hstep + kstep, voffB);
        PG8_WAIT_V(6); PG8_BAR;
    } else {
        PG8_STAGE(PG8_SB(0, 0), cB, voffB); PG8_STAGE(PG8_SA(0, 0), cA, voffA); PG8_STAGE(PG8_SB(0, 1), cB + hstep, voffB); PG8_STAGE(PG8_SA(0, 1), cA + hstep, voffA);
        if (wr == 1) PG8_BAR;
        PG8_WAIT_V(4); PG8_BAR;
        PG8_STAGE(PG8_SB(1, 0), cB + kstep, voffB); PG8_STAGE(PG8_SA(1, 0), cA + kstep, voffA); PG8_STAGE(PG8_SB(1, 1), cB + hstep + kstep, voffB);
        PG8_WAIT_V(6); PG8_BAR;
    }
    for (;;) {
        const bool has_next = S.next(ui + 1, nxt);
        const char* nA = has_next ? (const char*)(nxt.kind ? g.A1 : g.A) + (size_t)nxt.pm * tstep : cA; const char* nB = has_next ? (const char*)(nxt.kind ? g.Bt1 : g.Bt) + (size_t)nxt.pn * tstep : cB;
        for (int t = 0; t < nt; t += 2) {
            const bool last = (t == nt - 2);
            const char* a1 = cA + (size_t)(t + 1) * kstep;
            const char* a2 = last ? nA : cA + (size_t)(t + 2) * kstep; const char* b2 = last ? nB : cB + (size_t)(t + 2) * kstep;
            const char* a3 = a2 + kstep; const char* b3 = b2 + kstep;
            if (last && has_next) S.a_ready(nxt);
            if constexpr (SP2) {
            PG8_LDB(B0, 0, 0); PG8_LDB(B1, 0, 1); PG8_SCHED; PG8_LDA(At, 0, 0); PG8_STAGE(PG8_SA(1, 1), a1 + hstep, voffA);
            PG8_WAIT_V(8); PG8_WAIT_L(0); PG8_BAR; PG8_MMA(0, 0, At, B0); PG8_MMA(0, 1, At, B1); PG8_BAR; PG8_SCHED;
            PG8_LDA(At, 0, 1); PG8_STAGE(PG8_SB(0, 0), b2, voffB); PG8_STAGE(PG8_SB(0, 1), b2 + hstep, voffB); PG8_STAGE(PG8_SA(0, 0), a2, voffA);
            PG8_WAIT_V(8); PG8_WAIT_L(0); PG8_BAR; PG8_MMA(1, 0, At, B0); PG8_MMA(1, 1, At, B1); PG8_BAR; PG8_SCHED;
            PG8_LDB(B0, 1, 0); PG8_LDB(B1, 1, 1); PG8_SCHED; PG8_LDA(At, 1, 0); PG8_STAGE(PG8_SA(0, 1), a2 + hstep, voffA);
            PG8_WAIT_V(8); PG8_WAIT_L(0); PG8_BAR; PG8_MMA(0, 0, At, B0); PG8_MMA(0, 1, At, B1); PG8_BAR; PG8_SCHED;
            PG8_LDA(At, 1, 1); PG8_STAGE(PG8_SB(1, 0), b3, voffB); PG8_STAGE(PG8_SB(1, 1), b3 + hstep, voffB); PG8_STAGE(PG8_SA(1, 0), a3, voffA);
            PG8_WAIT_V(8); PG8_WAIT_L(0); PG8_BAR; PG8_MMA(1, 0, At, B0); PG8_MMA(1, 1, At, B1); PG8_BAR; PG8_SCHED;
            } else {
            PG8_LDB(B0, 0, 0); PG8_SCHED; PG8_LDA(At, 0, 0); PG8_STAGE(PG8_SA(1, 1), a1 + hstep, voffA);
            PG8_WAIT_L(8); PG8_BAR; PG8_WAIT_L(0); PG8_MMA(0, 0, At, B0); PG8_BAR; PG8_SCHED;
            PG8_LDB(B1, 0, 1); PG8_STAGE(PG8_SB(0, 0), b2, voffB);
            PG8_BAR; PG8_WAIT_L(0); PG8_MMA(0, 1, At, B1); PG8_BAR;
            PG8_LDA(At, 0, 1); PG8_STAGE(PG8_SA(0, 0), a2, voffA);
            PG8_BAR; PG8_WAIT_L(0); PG8_MMA(1, 0, At, B0); PG8_BAR; PG8_SCHED;
            PG8_STAGE(PG8_SB(0, 1), b2 + hstep, voffB);
            PG8_WAIT_V(6); PG8_BAR; PG8_MMA(1, 1, At, B1); PG8_BAR;
            PG8_LDB(B0, 1, 0); PG8_SCHED; PG8_LDA(At, 1, 0); PG8_STAGE(PG8_SA(0, 1), a2 + hstep, voffA);
            PG8_WAIT_L(8); PG8_BAR; PG8_WAIT_L(0); PG8_MMA(0, 0, At, B0); PG8_BAR; PG8_SCHED;
            PG8_LDB(B1, 1, 1); PG8_STAGE(PG8_SB(1, 0), b3, voffB);
            PG8_BAR; PG8_WAIT_L(0); PG8_MMA(0, 1, At, B1); PG8_BAR;
            PG8_LDA(At, 1, 1); PG8_STAGE(PG8_SA(1, 0), a3, voffA);
            PG8_BAR; PG8_WAIT_L(0); PG8_MMA(1, 0, At, B0); PG8_BAR; PG8_SCHED;
            PG8_STAGE(PG8_SB(1, 1), b3 + hstep, voffB);
            PG8_WAIT_V(6); PG8_BAR; PG8_MMA(1, 1, At, B1); PG8_BAR;
            }
        }
        if constexpr (ALIGN_EPI) { if (wr == 0) PG8_BAR; }
        if constexpr (!Epi::AFTER_DRAIN) { if constexpr (Epi::CHAIN) { if (cur.kind == 0) E.chain(acc, cur, wr, wc, fr, fq); else E(acc, cur, wr, wc, fr, fq); } else { E(acc, cur, wr, wc, fr, fq); } S.done(cur); }
        if (!has_next) break;
        if (!(Epi::CHAIN && cur.kind == 0))
#pragma unroll
        for (int a = 0; a < 2; ++a)
#pragma unroll
            for (int b = 0; b < 2; ++b)
#pragma unroll
                for (int m = 0; m < 4; ++m)
#pragma unroll
                    for (int n = 0; n < 2; ++n) acc[a][b][m][n] = (f32x4){0.f, 0.f, 0.f, 0.f};
        cur = nxt; cA = nA; cB = nB; ++ui;
        if constexpr (ALIGN_EPI) { if (wr == 1) PG8_BAR; }
    }
    PG8_WAIT_V(0);
    if constexpr (!ALIGN_EPI) { if (wr == 0) PG8_BAR; }
    PG8_BAR;
    if constexpr (Epi::AFTER_DRAIN) { E.fused(acc, cur, wr, wc, fr, fq, lds, wid, lane); S.done(cur); }
#undef PG8_SA
#undef PG8_SB
#undef PG8_STAGE
#undef PG8_LDA
#undef PG8_LDB
#undef PG8_MMA
#undef PG8_WAIT_V
#undef PG8_WAIT_L
#undef PG8_BAR
#undef PG8_SCHED
}
}

#define LAS __attribute__((address_space(3)))
typedef unsigned short bf16;
typedef unsigned v4u __attribute__((ext_vector_type(4)));
typedef unsigned v2u __attribute__((ext_vector_type(2)));
typedef float f32x4 __attribute__((ext_vector_type(4)));
constexpr int NB = 4, SEQ = 4096, T = NB * SEQ, D = 1024, INC = 4768, FFH = 2816;
constexpr float EPS = 1e-6f;
constexpr float QSCALE = 0.10206207261596577f * 1.4426950408889634f;
constexpr size_t MiB = 1u << 20;
constexpr size_t WS_SSQ = 0;
constexpr size_t WS_DEC = 5 * MiB / 4;
constexpr size_t WS_CTL = 7 * MiB / 4;
constexpr size_t WS_WIN = 2 * MiB;
constexpr size_t WS_WUQ = WS_WIN + (size_t)4864 * 1024 * 2;
constexpr size_t WS_WUKV = WS_WUQ + (size_t)1024 * 384 * 2;
constexpr size_t WS_WBA = WS_WUKV + (size_t)1024 * 256 * 2;
constexpr size_t WS_WBB = WS_WBA + (size_t)1024 * 512 * 2;
constexpr size_t WS_WOUT = WS_WBB + (size_t)1024 * 512 * 2;
constexpr size_t WS_WGU = WS_WOUT + (size_t)1024 * 1024 * 2;
constexpr size_t WS_WD = WS_WGU + (size_t)5632 * 1024 * 2;
constexpr size_t WS_WPG = WS_WD + (size_t)1024 * 2816 * 2;
constexpr size_t WS_WPP = WS_WPG + (size_t)1024 * 1024 * 2;
constexpr size_t WS_WEND = WS_WPP + (size_t)1024 * 256 * 2;
static_assert(WS_WEND <= 36 * MiB, "weights");
constexpr size_t WS_PB = 36 * MiB;
constexpr size_t WS_H = 44 * MiB;
constexpr size_t WS_ATT = 76 * MiB;
constexpr size_t WS_HQ = 92 * MiB;
constexpr size_t WS_LOGF = 108 * MiB;
constexpr size_t WS_HI = 140 * MiB;
constexpr size_t WS_SG = 156 * MiB;
constexpr size_t WS_Q = 172 * MiB;
constexpr size_t WS_K = 196 * MiB;
constexpr size_t WS_V = 220 * MiB;
constexpr size_t WS_GATES = 172 * MiB;
constexpr size_t WS_REC = 236 * MiB;
constexpr size_t WS_ACT = 140 * MiB;
constexpr size_t WS_SS1 = 236 * MiB, WS_SS2 = 237 * MiB, WS_SSP = 238 * MiB;
constexpr size_t WS_TAB = 252 * MiB;
constexpr size_t WS_KR = 254 * MiB;
constexpr size_t DO_CQ = 0;
constexpr size_t DO_CKV = 12 * MiB;
constexpr size_t DO_ST = 24 * MiB;

constexpr int LDS_BYTES = 147456;

struct Params {
    const float *x, *p; const int* pos;
    const float *mix_g, *w_in, *qa_g, *w_uq, *kva_g, *w_ukv, *qn_g, *kn_g, *lbl, *hgo_g, *w_br, *w_out, *ffn_g, *w_fg, *w_fu, *w_fd, *pg_g, *w_pg, *w_pp, *pp_g;
    float* out; unsigned char* ws; int ph_lo, ph_hi;
};

__device__ __forceinline__ float bf2f(bf16 b) { return __uint_as_float((unsigned)b << 16); }
__device__ __forceinline__ unsigned f2bf(float f) { unsigned u = __float_as_uint(f); return (u + 0x7fffu + ((u >> 16) & 1u)) >> 16; }
__device__ __forceinline__ unsigned pk2(float lo, float hi) { return pg8::cvtpk(lo, hi); }
__device__ __forceinline__ float wave_sum(float v) {
#pragma unroll
    for (int o = 1; o < 64; o <<= 1) v += __shfl_xor(v, o);
    return v;
}
#define LDS_WAIT() asm volatile("s_waitcnt lgkmcnt(0)" ::: "memory")
#define LDS_BAR() do { asm volatile("s_waitcnt lgkmcnt(0)" ::: "memory"); __builtin_amdgcn_s_barrier(); asm volatile("" ::: "memory"); } while (0)
__device__ __forceinline__ int lane_v() { int l; asm volatile("v_mbcnt_lo_u32_b32 %0, -1, 0\n\tv_mbcnt_hi_u32_b32 %0, -1, %0" : "=v"(l)); return l; }
#define TIDX(wv) ((wv) * 64 + lane_v())

__device__ __forceinline__ void srcmap(const Params& P, int mat, int v, const float*& sp, int& ld) {
    sp = nullptr; ld = 0;
    switch (mat) {
    case 0: { int c;
        if (v < 384) c = v; else if (v < 416) c = 640 + (v - 384); else if (v < 512) c = -1; else if (v < 768) c = 384 + (v - 512);
        else if (v < 1280) c = 672 + (v - 768); else if (v < 1792) c = 1184 + (v - 1280); else if (v < 2304) c = 1696 + (v - 1792); else if (v < 2816) c = 2208 + (v - 2304);
        else c = 2720 + (v - 2816);
        ld = INC; if (c >= 0) sp = P.w_in + c; break; }
    case 1: { const int h = v >> 7, j = v & 127; int c;
        if (j < 64) c = h * 96 + j; else if (j < 96) { const int jj = j - 64, g = jj >> 3, w = jj & 7; c = h * 96 + (w < 4 ? 64 + g * 4 + w : 80 + g * 4 + (w - 4)); } else c = -1;
        ld = 768; if (c >= 0) sp = P.w_uq + c; break; }
    case 2: ld = 1024; sp = P.w_ukv + v; break;
    case 3: ld = 1024; sp = P.w_br + v; break;
    case 4: ld = 1024; sp = P.w_br + (size_t)512 * 1024 + v; break;
    case 5: ld = 1024; sp = P.w_out + v; break;
    case 6: { const int t = v >> 8, w = v & 255; ld = FFH; sp = (w < 128) ? P.w_fg + t * 128 + w : P.w_fu + t * 128 + (w - 128); break; }
    case 7: ld = 1024; sp = P.w_fd + v; break;
    case 8: ld = 1024; sp = P.w_pg + v; break;
    default: ld = 1024; sp = P.w_pp + v; break;
    }
}
__device__ __forceinline__ void tr_item(const Params& P, int mat, const float* gain, int K, bf16* WT, LAS float* scr, int kb, int nb, int lane) {
    const int k0 = 64 * kb, n0 = 32 * nb;
    const float* sp; int ld; srcmap(P, mat, n0 + (lane & 31), sp, ld);
    float tv[32];
#pragma unroll
    for (int i = 0; i < 32; ++i) { const int kk = 2 * i + (lane >> 5); tv[i] = sp ? __builtin_nontemporal_load(sp + (size_t)(k0 + kk) * ld) : 0.f; }
#pragma unroll
    for (int i = 0; i < 32; ++i) { const int kk = 2 * i + (lane >> 5); float v = tv[i]; if (gain) v *= gain[k0 + kk]; scr[kk * 33 + (lane & 31)] = v; }
    LDS_WAIT();
    const int c = lane & 7;
#pragma unroll
    for (int j = 0; j < 4; ++j) { const int n = (lane >> 3) + 8 * j; const LAS float* s = scr + (8 * c) * 33 + n;
        v4u o; o.x = pk2(s[0 * 33], s[1 * 33]); o.y = pk2(s[2 * 33], s[3 * 33]); o.z = pk2(s[4 * 33], s[5 * 33]); o.w = pk2(s[6 * 33], s[7 * 33]);
        *(v4u*)(WT + (size_t)(n0 + n) * K + k0 + 8 * c) = o; }
    LDS_WAIT();
}
__device__ __forceinline__ void prep_late_weights(const Params& P, LAS unsigned char* lds, const int wv, int first) {
    if ((int)blockIdx.x < first) return;
    const int lane = lane_v(), wave = wv;
    LAS float* scr = (LAS float*)(lds + wave * 16384);
    const int gw = ((int)blockIdx.x - first) * 8 + wave, NGW = ((int)gridDim.x - first) * 8;
    unsigned char* ws = P.ws;
    constexpr int NITEMS = 3008;
    for (int it = gw; it < NITEMS; it += NGW) {
        int r = it;
        if (r < 1024) { tr_item(P, 0, P.mix_g, 1024, (bf16*)(ws + WS_WIN), scr, r >> 6, 88 + (r & 63), lane); continue; } r -= 1024;
        if (r < 192) { tr_item(P, 1, P.qa_g, 384, (bf16*)(ws + WS_WUQ), scr, r >> 5, r & 31, lane); continue; } r -= 192;
        if (r < 128) { tr_item(P, 2, P.kva_g, 256, (bf16*)(ws + WS_WUKV), scr, r >> 5, r & 31, lane); continue; } r -= 128;
        if (r < 256) { tr_item(P, 3, nullptr, 512, (bf16*)(ws + WS_WBA), scr, r >> 5, r & 31, lane); continue; } r -= 256;
        if (r < 256) { tr_item(P, 4, nullptr, 512, (bf16*)(ws + WS_WBB), scr, r >> 5, r & 31, lane); continue; } r -= 256;
        if (r < 512) { tr_item(P, 5, nullptr, 1024, (bf16*)(ws + WS_WOUT), scr, r >> 5, r & 31, lane); continue; } r -= 512;
        if (r < 512) { tr_item(P, 8, P.pg_g, 1024, (bf16*)(ws + WS_WPG), scr, r >> 5, r & 31, lane); continue; } r -= 512;
        tr_item(P, 9, nullptr, 256, (bf16*)(ws + WS_WPP), scr, r >> 5, r & 31, lane);
    }
}
__device__ __forceinline__ void prep_wd(const Params& P, LAS unsigned char* lds, const int wv, int first) {
    if ((int)blockIdx.x < first) return;
    const int lane = lane_v(), wave = wv;
    LAS float* scr = (LAS float*)(lds + wave * 16384);
    const int gw = ((int)blockIdx.x - first) * 8 + wave, NGW = ((int)gridDim.x - first) * 8;
    for (int r = gw; r < 1408; r += NGW) tr_item(P, 7, nullptr, 2816, (bf16*)(P.ws + WS_WD), scr, r >> 5, r & 31, lane);
}
__device__ __forceinline__ void phase_prep(const Params& P, LAS unsigned char* lds, const int wv) {
    const int tid = TIDX(wv), lane = tid & 63, wave = tid >> 6;
    LAS float* scr = (LAS float*)(lds + wave * 16384);
    const int gw = blockIdx.x * 8 + wave, NGW = gridDim.x * 8;
    unsigned char* ws = P.ws;
    for (int it = gw; it < 1408; it += NGW) tr_item(P, 0, P.mix_g, 1024, (bf16*)(ws + WS_WIN), scr, it / 88, it % 88, lane);
    for (int it = gw; it < 2816; it += NGW) tr_item(P, 6, P.ffn_g, 1024, (bf16*)(ws + WS_WGU), scr, it / 176, it % 176, lane);
    bf16* H = (bf16*)(ws + WS_H); bf16* PB = (bf16*)(ws + WS_PB); float* TAB = (float*)(ws + WS_TAB);
    for (int m4 = gw * 4; m4 < T; m4 += NGW * 4) {
        f32x4 v[4][4]; f32x4 pv[4];
#pragma unroll
        for (int r = 0; r < 4; ++r) { const f32x4* xr = (const f32x4*)(P.x + (size_t)(m4 + r) * D) + lane;
#pragma unroll
            for (int j = 0; j < 4; ++j) v[r][j] = __builtin_nontemporal_load(xr + 64 * j);
            pv[r] = __builtin_nontemporal_load((const f32x4*)(P.p + (size_t)(m4 + r) * 256) + lane); }
#pragma unroll
        for (int r = 0; r < 4; ++r) { const int m = m4 + r; float s = 0.f;
#pragma unroll
            for (int j = 0; j < 4; ++j) s += (v[r][j][0] * v[r][j][0] + v[r][j][1] * v[r][j][1]) + (v[r][j][2] * v[r][j][2] + v[r][j][3] * v[r][j][3]);
            const float rr = 1.0f / sqrtf(wave_sum(s) * (1.0f / D) + EPS);
            v2u* o8 = (v2u*)(H + (size_t)m * D) + lane;
#pragma unroll
            for (int j = 0; j < 4; ++j) { v2u w; w.x = pk2(v[r][j][0] * rr, v[r][j][1] * rr); w.y = pk2(v[r][j][2] * rr, v[r][j][3] * rr); o8[64 * j] = w; }
            v2u w; w.x = pk2(pv[r][0], pv[r][1]); w.y = pk2(pv[r][2], pv[r][3]); *((v2u*)(PB + (size_t)m * 256) + lane) = w; }
        { const int m = m4 + (lane >> 4), l16 = lane & 15;
            double inv = 1.0; for (int i = 0; i < l16; ++i) inv *= 0.5623413251903491;
            const double rev = (double)P.pos[m] * inv * 0.15915494309189535; const float fr = (float)(rev - floor(rev));
            TAB[(size_t)m * 32 + l16] = __builtin_amdgcn_cosf(fr); TAB[(size_t)m * 32 + 16 + l16] = __builtin_amdgcn_sinf(fr); }
    }
}

typedef short bf16x8_t __attribute__((ext_vector_type(8)));
typedef short s16x4_t __attribute__((ext_vector_type(4)));
typedef float f32x16_t __attribute__((ext_vector_type(16)));
constexpr int AT_KRS = 208, AT_VRS = 144, AT_KBUF = 64 * AT_KRS, AT_VBUF = 64 * AT_VRS;
__device__ __forceinline__ int crow(int r, int hi) { return (r & 3) + 8 * (r >> 2) + 4 * hi; }
__device__ __forceinline__ s16x4_t vtr(const LAS unsigned char* p) { return __builtin_bit_cast(s16x4_t, __builtin_amdgcn_ds_read_tr16_b64_v4i16((LAS s16x4_t*)p)); }
__device__ __forceinline__ float max3_asm(float a, float b, float c) { float r; asm("v_max3_f32 %0, %1, %2, %3" : "=v"(r) : "v"(a), "v"(b), "v"(c)); return r; }
__device__ __forceinline__ void attn_unit(const Params& P, LAS unsigned char* lds, int bh, int qb, const int wv) {
    const int tid = TIDX(wv), lane = tid & 63, wave = wv, q32 = lane & 31, hi = lane >> 5;
    unsigned char* ws = P.ws;
    const bf16* Q = (const bf16*)(ws + WS_Q); const bf16* K = (const bf16*)(ws + WS_K); const bf16* V = (const bf16*)(ws + WS_V); bf16* ATT = (bf16*)(ws + WS_ATT);
    LAS unsigned char* kb0 = lds; LAS unsigned char* vb0 = lds + 2 * AT_KBUF;
    const int NT = 4 * (qb + 1);
    const v4u* Kg = (const v4u*)(K + (size_t)bh * SEQ * 96); const v4u* Vg = (const v4u*)(V + (size_t)bh * SEQ * 64);
    const int kc0 = tid, kc1 = tid + 512;
    const int kl0 = (kc0 / 12) * AT_KRS + (kc0 % 12) * 16, kl1 = (kc1 / 12) * AT_KRS + (kc1 % 12) * 16, vl = (tid >> 3) * AT_VRS + (tid & 7) * 16;
    bf16x8_t qf[6];
    { const bf16* Qw = Q + ((size_t)bh * SEQ + qb * 256 + wave * 32 + q32) * 96;
#pragma unroll
      for (int t = 0; t < 6; ++t) qf[t] = *(const bf16x8_t*)(Qw + 16 * t + 8 * hi); }
    f32x16_t o0, o1;
#pragma unroll
    for (int r = 0; r < 16; ++r) { o0[r] = 0.f; o1[r] = 0.f; }
    float lsum = 0.f;
    const int i16 = lane & 15, g16 = (lane >> 4) & 1;
    const int vlane = (4 * hi + (i16 >> 2)) * AT_VRS + (16 * g16 + 4 * (i16 & 3)) * 2;
    v4u ak0, ak1, av, bk0, bk1, bv;
#define AT_LOAD(k0_, k1_, v_, t_) do { k0_ = Kg[(size_t)(t_) * 768 + kc0]; if (tid < 256) k1_ = Kg[(size_t)(t_) * 768 + kc1]; v_ = Vg[(size_t)(t_) * 512 + tid]; } while (0)
#define AT_STORE(k0_, k1_, v_, buf_) do { LAS unsigned char* kbn_ = kb0 + (buf_) * AT_KBUF; LAS unsigned char* vbn_ = vb0 + (buf_) * AT_VBUF; \
        *(LAS v4u*)(kbn_ + kl0) = k0_; if (tid < 256) *(LAS v4u*)(kbn_ + kl1) = k1_; *(LAS v4u*)(vbn_ + vl) = v_; } while (0)
#define AT_PACK(pk_, sv_, b_) do { v4u w_; _Pragma("unroll") for (int jj = 0; jj < 4; ++jj) w_[jj] = pk2(sv_[(b_) + 2 * jj], sv_[(b_) + 2 * jj + 1]); pk_ = __builtin_bit_cast(bf16x8_t, w_); } while (0)
#define AT_COMPUTE(cur_, kt_) do { \
        const int jrel = (kt_) - 4 * qb; \
        if (jrel * 64 <= wave * 32 + 31) { \
            const LAS unsigned char* kb = kb0 + (cur_) * AT_KBUF; const LAS unsigned char* vb = vb0 + (cur_) * AT_VBUF; \
            bf16x8_t vf[8]; \
            _Pragma("unroll") for (int s = 0; s < 4; ++s) _Pragma("unroll") for (int db = 0; db < 2; ++db) { \
                const s16x4_t lo = vtr(vb + vlane + (16 * s) * AT_VRS + db * 64); const s16x4_t hi4 = vtr(vb + vlane + (16 * s + 8) * AT_VRS + db * 64); \
                vf[2 * s + db] = __builtin_shufflevector(lo, hi4, 0, 1, 2, 3, 4, 5, 6, 7); } \
            f32x16_t s0, s1; \
            _Pragma("unroll") for (int r = 0; r < 16; ++r) { s0[r] = 0.f; s1[r] = 0.f; } \
            _Pragma("unroll") for (int t = 0; t < 6; ++t) { \
                const bf16x8_t a0 = *(const LAS bf16x8_t*)(kb + q32 * AT_KRS + (16 * t + 8 * hi) * 2); \
                s0 = __builtin_amdgcn_mfma_f32_32x32x16_bf16(a0, qf[t], s0, 0, 0, 0); } \
            _Pragma("unroll") for (int t = 0; t < 6; ++t) { \
                const bf16x8_t a1 = *(const LAS bf16x8_t*)(kb + (q32 + 32) * AT_KRS + (16 * t + 8 * hi) * 2); \
                s1 = __builtin_amdgcn_mfma_f32_32x32x16_bf16(a1, qf[t], s1, 0, 0, 0); } \
            bf16x8_t pb0, pb1, pb2, pb3; float ps = 0.f; \
            if (jrel >= 0) {                            \
                const int qrel = wave * 32 + q32; \
                _Pragma("unroll") for (int r = 0; r < 16; ++r) { const int kr = jrel * 64 + crow(r, hi); s0[r] = (kr > qrel) ? 0.f : __builtin_amdgcn_exp2f(s0[r]); s1[r] = (kr + 32 > qrel) ? 0.f : __builtin_amdgcn_exp2f(s1[r]); ps += s0[r] + s1[r]; } \
                AT_PACK(pb0, s0, 0); AT_PACK(pb1, s0, 8); AT_PACK(pb2, s1, 0); AT_PACK(pb3, s1, 8); \
                o0 = __builtin_amdgcn_mfma_f32_32x32x16_bf16(vf[0], pb0, o0, 0, 0, 0); o1 = __builtin_amdgcn_mfma_f32_32x32x16_bf16(vf[1], pb0, o1, 0, 0, 0); \
                o0 = __builtin_amdgcn_mfma_f32_32x32x16_bf16(vf[2], pb1, o0, 0, 0, 0); o1 = __builtin_amdgcn_mfma_f32_32x32x16_bf16(vf[3], pb1, o1, 0, 0, 0); \
                o0 = __builtin_amdgcn_mfma_f32_32x32x16_bf16(vf[4], pb2, o0, 0, 0, 0); o1 = __builtin_amdgcn_mfma_f32_32x32x16_bf16(vf[5], pb2, o1, 0, 0, 0); \
                o0 = __builtin_amdgcn_mfma_f32_32x32x16_bf16(vf[6], pb3, o0, 0, 0, 0); o1 = __builtin_amdgcn_mfma_f32_32x32x16_bf16(vf[7], pb3, o1, 0, 0, 0); \
            } else { \
                _Pragma("unroll") for (int r = 0; r < 16; ++r) { s0[r] = __builtin_amdgcn_exp2f(s0[r]); ps += s0[r]; } \
                AT_PACK(pb0, s0, 0); AT_PACK(pb1, s0, 8); \
                o0 = __builtin_amdgcn_mfma_f32_32x32x16_bf16(vf[0], pb0, o0, 0, 0, 0); o1 = __builtin_amdgcn_mfma_f32_32x32x16_bf16(vf[1], pb0, o1, 0, 0, 0); \
                o0 = __builtin_amdgcn_mfma_f32_32x32x16_bf16(vf[2], pb1, o0, 0, 0, 0); o1 = __builtin_amdgcn_mfma_f32_32x32x16_bf16(vf[3], pb1, o1, 0, 0, 0); \
                _Pragma("unroll") for (int r = 0; r < 16; ++r) { s1[r] = __builtin_amdgcn_exp2f(s1[r]); ps += s1[r]; } \
                AT_PACK(pb2, s1, 0); AT_PACK(pb3, s1, 8); \
                o0 = __builtin_amdgcn_mfma_f32_32x32x16_bf16(vf[4], pb2, o0, 0, 0, 0); o1 = __builtin_amdgcn_mfma_f32_32x32x16_bf16(vf[5], pb2, o1, 0, 0, 0); \
                o0 = __builtin_amdgcn_mfma_f32_32x32x16_bf16(vf[6], pb3, o0, 0, 0, 0); o1 = __builtin_amdgcn_mfma_f32_32x32x16_bf16(vf[7], pb3, o1, 0, 0, 0); \
            } \
            lsum += ps; \
        } } while (0)
    AT_LOAD(ak0, ak1, av, 0);
    AT_LOAD(bk0, bk1, bv, 1);
    LDS_BAR();
    AT_STORE(ak0, ak1, av, 0);
    LDS_BAR();
    for (int kt = 0; kt < NT; kt += 2) {
        if (kt + 2 < NT) AT_LOAD(ak0, ak1, av, kt + 2);
        AT_COMPUTE(0, kt);
        AT_STORE(bk0, bk1, bv, 1);
        LDS_BAR();
        if (kt + 3 < NT) AT_LOAD(bk0, bk1, bv, kt + 3);
        AT_COMPUTE(1, kt + 1);
        if (kt + 2 < NT) AT_STORE(ak0, ak1, av, 0);
        LDS_BAR();
    }
#undef AT_LOAD
#undef AT_STORE
#undef AT_COMPUTE
#undef AT_PACK
    lsum += __shfl_xor(lsum, 32);
    const float il = 1.0f / lsum;
    const int b = bh >> 3, h = bh & 7;
    bf16* orow = ATT + ((size_t)b * SEQ + qb * 256 + wave * 32 + q32) * 512 + h * 64;
#pragma unroll
    for (int g = 0; g < 4; ++g) { v2u w0, w1;
        w0.x = pk2(o0[4 * g] * il, o0[4 * g + 1] * il); w0.y = pk2(o0[4 * g + 2] * il, o0[4 * g + 3] * il);
        w1.x = pk2(o1[4 * g] * il, o1[4 * g + 1] * il); w1.y = pk2(o1[4 * g + 2] * il, o1[4 * g + 3] * il);
        *(v2u*)(orow + 8 * g + 4 * hi) = w0; *(v2u*)(orow + 32 + 8 * g + 4 * hi) = w1; }
}
__device__ __forceinline__ void phase_attn(const Params& P, LAS unsigned char* lds, const int wv) {
    const int G = gridDim.x, bx = blockIdx.x, vcu = (G % 8 == 0) ? (bx % 8) * (G / 8) + bx / 8 : bx;
    for (int c = vcu; c < 256; c += G) { const int bh = c >> 3, s = c & 7; attn_unit(P, lds, bh, 15 - s, wv); attn_unit(P, lds, bh, s, wv); }
}

constexpr int HG_RS = 272, HG_KT_RS = 144;
__device__ __forceinline__ void hgrn_local_phase(const Params& P, LAS unsigned char* lds, const int wv) {
    const int tid = TIDX(wv), lane = tid & 63, j = tid >> 7, k = tid & 127, q32 = lane & 31, hi = lane >> 5, i16 = lane & 15, g16 = (lane >> 4) & 1;
    const float* LOGF = (const float*)(P.ws + WS_LOGF); const bf16* HI = (const bf16*)(P.ws + WS_HI);
    LAS unsigned char* KT = lds; LAS unsigned char* VS = lds + 18432; LAS float* TOT = (LAS float*)(lds + 18432 + 17408);
    float g[16]; v4u v0, v1;
#define HL_LOAD(u_) do { const int bh_ = (u_) >> 6, c_ = (u_) & 63; const size_t m0_ = (size_t)(bh_ >> 2) * SEQ + c_ * 64; const int h_ = bh_ & 3; \
        _Pragma("unroll") for (int i = 0; i < 16; ++i) g[i] = LOGF[(m0_ + 16 * j + i) * 512 + h_ * 128 + k]; \
        v0 = *(const v4u*)(HI + (m0_ + (tid >> 4)) * 512 + h_ * 128 + (tid & 15) * 8); v1 = *(const v4u*)(HI + (m0_ + 32 + (tid >> 4)) * 512 + h_ * 128 + (tid & 15) * 8); } while (0)
    int unit = blockIdx.x;
    if (unit < 1024) HL_LOAD(unit);
    for (; unit < 1024; unit += gridDim.x) {
    LDS_BAR();
    *(LAS v4u*)(VS + (tid >> 4) * HG_RS + (tid & 15) * 16) = v0; *(LAS v4u*)(VS + (32 + (tid >> 4)) * HG_RS + (tid & 15) * 16) = v1;
    float cs[16]; float run = 0.f;
#pragma unroll
    for (int i = 0; i < 16; ++i) { run += g[i]; cs[i] = run; }
    TOT[j * 128 + k] = run;
    LDS_BAR();
    const float t0 = TOT[k], t1 = TOT[128 + k], t2 = TOT[256 + k], t3 = TOT[384 + k];
    const float pre = (j > 0 ? t0 : 0.f) + (j > 1 ? t1 : 0.f) + (j > 2 ? t2 : 0.f), last = (t0 + t1) + (t2 + t3);
    { v4u w0, w1;
#pragma unroll
      for (int i = 0; i < 8; ++i) { const float a = (1.0f - __expf(g[2 * i])) * __expf(last - (pre + cs[2 * i])), bq = (1.0f - __expf(g[2 * i + 1])) * __expf(last - (pre + cs[2 * i + 1]));
          if (i < 4) w0[i] = pk2(a, bq); else w1[i - 4] = pk2(a, bq); }
      *(LAS v4u*)(KT + k * HG_KT_RS + j * 32) = w0; *(LAS v4u*)(KT + k * HG_KT_RS + j * 32 + 16) = w1; }
    if (j == 0) ((float*)(P.ws + WS_DEC))[(size_t)unit * 128 + k] = __expf(last);
    LDS_BAR();
    if (unit + (int)gridDim.x < 1024) HL_LOAD(unit + (int)gridDim.x);
    const int kb = wv >> 1, vb0 = 2 * (wv & 1);
    f32x16_t a0, a1;
#pragma unroll
    for (int r = 0; r < 16; ++r) { a0[r] = 0.f; a1[r] = 0.f; }
#pragma unroll
    for (int ks = 0; ks < 4; ++ks) {
        const bf16x8_t A = *(const LAS bf16x8_t*)(KT + (32 * kb + q32) * HG_KT_RS + (16 * ks + 8 * hi) * 2);
        const LAS unsigned char* vp = VS + (16 * ks + 8 * hi + (i16 >> 2)) * HG_RS + (32 * vb0 + 16 * g16 + 4 * (i16 & 3)) * 2;
        { const s16x4_t lo = vtr(vp), h4 = vtr(vp + 4 * HG_RS); a0 = __builtin_amdgcn_mfma_f32_32x32x16_bf16(A, __builtin_shufflevector(lo, h4, 0, 1, 2, 3, 4, 5, 6, 7), a0, 0, 0, 0); }
        { const s16x4_t lo = vtr(vp + 64), h4 = vtr(vp + 64 + 4 * HG_RS); a1 = __builtin_amdgcn_mfma_f32_32x32x16_bf16(A, __builtin_shufflevector(lo, h4, 0, 1, 2, 3, 4, 5, 6, 7), a1, 0, 0, 0); }
    }
    bf16* U = (bf16*)((unsigned char*)P.out + DO_ST) + (size_t)unit * 16384;
#pragma unroll
    for (int r = 0; r < 16; ++r) { const int kr = 32 * kb + crow(r, hi); U[kr * 128 + 32 * vb0 + q32] = (bf16)f2bf(a0[r]); U[kr * 128 + 32 * vb0 + 32 + q32] = (bf16)f2bf(a1[r]); }
    }
#undef HL_LOAD
}
__device__ __forceinline__ void hgrn_scan(const Params& P, const int wv) {
    const int tid = TIDX(wv);
    for (int e = blockIdx.x * 512 + tid; e < 131072; e += gridDim.x * 512) {
        const int bh = e >> 13, k = (e >> 6) & 127, vp = e & 63;
        unsigned* base = (unsigned*)((unsigned char*)P.out + DO_ST) + ((size_t)(bh * 64) * 128 + k) * 64 + vp;
        const float* dec = (const float*)(P.ws + WS_DEC) + (size_t)(bh * 64) * 128 + k;
        float s0 = 0.f, s1 = 0.f;
#pragma unroll 8
        for (int c = 0; c < 64; ++c) { const unsigned u = base[(size_t)c * 8192]; const float d = dec[c * 128];
            base[(size_t)c * 8192] = pk2(s0, s1); s0 = d * s0 + __uint_as_float(u << 16); s1 = d * s1 + __uint_as_float(u & 0xffff0000u); }
    }
}
__device__ __forceinline__ void hgrn_out_phase(const Params& P, LAS unsigned char* lds, const int wv) {
    const int tid = TIDX(wv), lane = tid & 63, j = tid >> 7, k = tid & 127, q32 = lane & 31, hi = lane >> 5, i16 = lane & 15, g16 = (lane >> 4) & 1;
    const float* LOGF = (const float*)(P.ws + WS_LOGF); const bf16* HQ = (const bf16*)(P.ws + WS_HQ); const bf16* HI = (const bf16*)(P.ws + WS_HI); const bf16* SG = (const bf16*)(P.ws + WS_SG);
    bf16* REC = (bf16*)(P.ws + WS_REC);
    LAS unsigned char* QT = lds; LAS unsigned char* QA = lds + 17408; LAS unsigned char* KB = lds + 34816; LAS unsigned char* VS = lds + 52224; LAS unsigned char* STL = lds + 69632;
    LAS float* TOT = (LAS float*)(lds + 104448); LAS float* XN = (LAS float*)(lds + 106496);
    float g[16]; bf16 qr[16]; v4u v0, v1, s4[4];
#define HG_LOAD(u_) do { const int bh_ = (u_) >> 6, c_ = (u_) & 63; const size_t m0_ = (size_t)(bh_ >> 2) * SEQ + c_ * 64; const int h_ = bh_ & 3; \
        const bf16* ST_ = (const bf16*)((unsigned char*)P.out + DO_ST) + (size_t)(u_) * 16384; \
        _Pragma("unroll") for (int i = 0; i < 16; ++i) { const size_t gi = (m0_ + 16 * j + i) * 512 + h_ * 128 + k; g[i] = LOGF[gi]; qr[i] = HQ[gi]; } \
        v0 = *(const v4u*)(HI + (m0_ + (tid >> 4)) * 512 + h_ * 128 + (tid & 15) * 8); v1 = *(const v4u*)(HI + (m0_ + 32 + (tid >> 4)) * 512 + h_ * 128 + (tid & 15) * 8); \
        _Pragma("unroll") for (int i = 0; i < 4; ++i) s4[i] = *(const v4u*)(ST_ + (size_t)((tid >> 4) + 32 * i) * 128 + (tid & 15) * 8); } while (0)
    int unit = blockIdx.x;
    if (unit < 1024) HG_LOAD(unit);
    for (; unit < 1024; unit += gridDim.x) {
    const int bh = unit >> 6, c = unit & 63, b = bh >> 2, h = bh & 3;
    const size_t m0 = (size_t)b * SEQ + c * 64;
    LDS_BAR();
    *(LAS v4u*)(VS + (tid >> 4) * HG_RS + (tid & 15) * 16) = v0; *(LAS v4u*)(VS + (32 + (tid >> 4)) * HG_RS + (tid & 15) * 16) = v1;
#pragma unroll
    for (int i = 0; i < 4; ++i) *(LAS v4u*)(STL + ((tid >> 4) + 32 * i) * HG_RS + (tid & 15) * 16) = s4[i];
    float cs[16]; float run = 0.f;
#pragma unroll
    for (int i = 0; i < 16; ++i) { run += g[i]; cs[i] = run; }
    TOT[j * 128 + k] = run;
    LDS_BAR();
    const float t0 = TOT[k], t1 = TOT[128 + k], t2 = TOT[256 + k];
    const float pre = (j > 0 ? t0 : 0.f) + (j > 1 ? t1 : 0.f) + (j > 2 ? t2 : 0.f), ref = t0 + t1;
#pragma unroll
    for (int i = 0; i < 16; ++i) { const int t = 16 * j + i; const float cum = pre + cs[i], kk = 1.0f - __expf(g[i]); const float qi = bf2f(qr[i]);
        *(LAS bf16*)(QT + t * HG_RS + k * 2) = (bf16)f2bf(qi * __expf(cum));
        *(LAS bf16*)(QA + t * HG_RS + k * 2) = (bf16)f2bf(qi * __expf(fminf(cum - ref, 80.f)));
        *(LAS bf16*)(KB + t * HG_RS + k * 2) = (bf16)f2bf(kk * __expf(fminf(ref - cum, 80.f))); }
    LDS_BAR();
    if (unit + (int)gridDim.x < 1024) HG_LOAD(unit + (int)gridDim.x);
    const int tb = wv >> 2, vb = wv & 3;
    f32x16_t att[2];
#pragma unroll
    for (int sb = 0; sb < 2; ++sb) {
#pragma unroll
        for (int r = 0; r < 16; ++r) att[sb][r] = 0.f;
        if (sb <= tb) {
#pragma unroll
            for (int ks = 0; ks < 8; ++ks) {
                const bf16x8_t A = *(const LAS bf16x8_t*)(KB + (32 * sb + q32) * HG_RS + (16 * ks + 8 * hi) * 2);
                const bf16x8_t Bq = *(const LAS bf16x8_t*)(QA + (32 * tb + q32) * HG_RS + (16 * ks + 8 * hi) * 2);
                att[sb] = __builtin_amdgcn_mfma_f32_32x32x16_bf16(A, Bq, att[sb], 0, 0, 0);
            }
            if (sb == tb) {
#pragma unroll
                for (int r = 0; r < 16; ++r) if (crow(r, hi) > q32) att[sb][r] = 0.f;
            }
        }
    }
    f32x16_t o;
#pragma unroll
    for (int r = 0; r < 16; ++r) o[r] = 0.f;
#pragma unroll
    for (int ks = 0; ks < 8; ++ks) {
        const LAS unsigned char* sp = STL + (16 * ks + 8 * hi + (i16 >> 2)) * HG_RS + (32 * vb + 16 * g16 + 4 * (i16 & 3)) * 2;
        const s16x4_t lo = vtr(sp), h4 = vtr(sp + 4 * HG_RS);
        const bf16x8_t Bq = *(const LAS bf16x8_t*)(QT + (32 * tb + q32) * HG_RS + (16 * ks + 8 * hi) * 2);
        o = __builtin_amdgcn_mfma_f32_32x32x16_bf16(__builtin_shufflevector(lo, h4, 0, 1, 2, 3, 4, 5, 6, 7), Bq, o, 0, 0, 0);
    }
#pragma unroll
    for (int sb = 0; sb < 2; ++sb) {
        if (sb <= tb) {
#pragma unroll
            for (int k2 = 0; k2 < 2; ++k2) {
                v4u w;
#pragma unroll
                for (int jj = 0; jj < 4; ++jj) w[jj] = pk2(att[sb][8 * k2 + 2 * jj], att[sb][8 * k2 + 2 * jj + 1]);
                const LAS unsigned char* vp = VS + (32 * sb + 16 * k2 + 4 * hi + (i16 >> 2)) * HG_RS + (32 * vb + 16 * g16 + 4 * (i16 & 3)) * 2;
                const s16x4_t lo = vtr(vp), h4 = vtr(vp + 8 * HG_RS);
                o = __builtin_amdgcn_mfma_f32_32x32x16_bf16(__builtin_shufflevector(lo, h4, 0, 1, 2, 3, 4, 5, 6, 7), __builtin_bit_cast(bf16x8_t, w), o, 0, 0, 0);
            }
        }
    }
    float ss = 0.f;
#pragma unroll
    for (int r = 0; r < 16; ++r) ss += o[r] * o[r];
    ss += __shfl_xor(ss, 32);
    if (hi == 0) XN[(32 * tb + q32) * 4 + vb] = ss;
    LDS_BAR();
    const f32x4 xs = *(const LAS f32x4*)(XN + (32 * tb + q32) * 4);
    const float rn = 1.0f / sqrtf(((xs[0] + xs[1]) + (xs[2] + xs[3])) * (1.0f / 128.0f) + EPS);
    const size_t ro = (m0 + 32 * tb + q32) * 512 + h * 128;
#pragma unroll
    for (int g4 = 0; g4 < 4; ++g4) { const int vv = 32 * vb + 8 * g4 + 4 * hi;
        const f32x4 gn = *(const f32x4*)(P.hgo_g + vv); const v2u sg = *(const v2u*)(SG + ro + vv);
        v2u w; w.x = pk2(o[4 * g4] * rn * gn[0] * __uint_as_float(sg.x << 16), o[4 * g4 + 1] * rn * gn[1] * __uint_as_float(sg.x & 0xffff0000u));
        w.y = pk2(o[4 * g4 + 2] * rn * gn[2] * __uint_as_float(sg.y << 16), o[4 * g4 + 3] * rn * gn[3] * __uint_as_float(sg.y & 0xffff0000u));
        *(v2u*)(REC + ro + vv) = w; }
    }
#undef HG_LOAD
}

__device__ __forceinline__ void grid_bar(unsigned* ctr, unsigned target, int tid) {
    asm volatile("s_waitcnt vmcnt(0) lgkmcnt(0)" ::: "memory");
    __syncthreads();
    if (tid == 0) {
        __builtin_amdgcn_fence(__ATOMIC_RELEASE, "agent");
        asm volatile("s_waitcnt vmcnt(0)" ::: "memory");
        __hip_atomic_fetch_add(ctr, 1u, __ATOMIC_RELAXED, __HIP_MEMORY_SCOPE_AGENT);
        unsigned spins = 0;
        while (__hip_atomic_load(ctr, __ATOMIC_RELAXED, __HIP_MEMORY_SCOPE_AGENT) < target) { __builtin_amdgcn_s_sleep(2); if (++spins > (1u << 26)) break; }
        __builtin_amdgcn_fence(__ATOMIC_ACQUIRE, "agent");
        asm volatile("s_waitcnt vmcnt(0)" ::: "memory");
    }
    __syncthreads();
}

#define XB_TMO      128
#define XB_XCNT(j)  (256  + 64 * (j))
#define XB_XSUB(j)  (1280 + 64 * (j))
#define XB_XGEN(j)  (2304 + 64 * (j))
#define XB_TOP      3328
#define XB_TOPGEN   3392
#define XCD_BAR_WORDS 3456
#define XB_SPIN_CAP (1u << 18)

__device__ __forceinline__ unsigned xb_ld(unsigned* p)              { return __hip_atomic_load(p, __ATOMIC_RELAXED, __HIP_MEMORY_SCOPE_AGENT); }
__device__ __forceinline__ unsigned xb_add(unsigned* p, unsigned v) { return __hip_atomic_fetch_add(p, v, __ATOMIC_RELAXED, __HIP_MEMORY_SCOPE_AGENT); }
__device__ __forceinline__ unsigned xb_xcc_id() { return (unsigned)__builtin_amdgcn_s_getreg((3 << 11) | 20) & 0xFu; }
#define XB_SPIN(cond, bar) do { unsigned _sp = 0; while (cond) { __builtin_amdgcn_s_sleep(1); \
    if ((++_sp & 255u) == 0u) { if (xb_ld(&(bar)[XB_TMO])) break; if (_sp > XB_SPIN_CAP) { atomicAdd(&(bar)[XB_TMO], 1u); break; } } } } while (0)

struct XcdBarrier {
    unsigned* bar; unsigned x;
    volatile LAS unsigned* st;
};

__device__ __forceinline__ XcdBarrier xcd_barrier_post(unsigned* bar, volatile LAS unsigned* st, int tid) {
    XcdBarrier b; b.bar = bar; b.x = xb_xcc_id(); b.st = st;
    if (tid == 0) (void)xb_add(&bar[XB_XCNT(b.x)], 1u);
    return b;
}
__device__ __forceinline__ void xcd_barrier_complete(unsigned* bar, unsigned x, unsigned& nloc, unsigned& nx) {
    const unsigned G = gridDim.x * gridDim.y * gridDim.z;
    unsigned sum, cnt, mine, sp = 0u;
    for (;;) {
        sum = 0u; cnt = 0u; mine = 0u;
#pragma unroll
        for (unsigned j = 0; j < 16; ++j) { const unsigned c = xb_ld(&bar[XB_XCNT(j)]); sum += c; cnt += (c > 0u) ? 1u : 0u; mine = (j == x) ? c : mine; }
        if (sum == G) break;
        __builtin_amdgcn_s_sleep(1);
        if ((++sp & 255u) == 0u) { if (xb_ld(&bar[XB_TMO])) break; if (sp > XB_SPIN_CAP) { atomicAdd(&bar[XB_TMO], 1u); break; } }
    }
    nloc = mine > 0u ? mine : 1u; nx = cnt > 0u ? cnt : 1u;
}

__device__ __forceinline__ void xcd_barrier(const XcdBarrier& b, int tid) {
    asm volatile("s_waitcnt vmcnt(0)" ::: "memory");
    __syncthreads();
    if (tid == 0) {
        unsigned* bar = b.bar;
        __builtin_amdgcn_s_waitcnt(0);
        unsigned nloc = b.st[0], nx = b.st[1];
        if (nloc == 0u) { xcd_barrier_complete(bar, b.x, nloc, nx); b.st[0] = nloc; b.st[1] = nx; }
        const unsigned old = xb_add(&bar[XB_XSUB(b.x)], 1u);
        const unsigned gen = old / nloc;
        if (old + 1u == (gen + 1u) * nloc) {
            __builtin_amdgcn_fence(__ATOMIC_RELEASE, "agent");
            asm volatile("s_waitcnt vmcnt(0)" ::: "memory");
            const unsigned og = xb_add(&bar[XB_TOP], 1u);
            const unsigned tg = og / nx;
            if (og + 1u == (tg + 1u) * nx) xb_add(&bar[XB_TOPGEN], 1u);
            else XB_SPIN(xb_ld(&bar[XB_TOPGEN]) == tg, bar);
            __builtin_amdgcn_fence(__ATOMIC_ACQUIRE, "agent");
            xb_add(&bar[XB_XGEN(b.x)], 1u);
            asm volatile("s_waitcnt vmcnt(0)" ::: "memory");
        } else {
            XB_SPIN(xb_ld(&bar[XB_XGEN(b.x)]) == gen, bar);
            __builtin_amdgcn_fence(__ATOMIC_ACQUIRE, "agent");
            asm volatile("s_waitcnt vmcnt(0)" ::: "memory");
        }
    }
    __syncthreads();
}

constexpr int NPHASE = 10;
#ifndef PROBE_DUP
#define PROBE_DUP 0
#endif
#define DUPK(k, ...) { __VA_ARGS__ } if constexpr (((PROBE_DUP >> (k)) & 1) != 0) { __syncthreads(); __VA_ARGS__ }
__global__ void __launch_bounds__(512, 2) fwd(Params P) {
    extern __shared__ __attribute__((aligned(16))) unsigned char lds_raw[];
    LAS unsigned char* lds = (LAS unsigned char*)lds_raw;
    cg::grid_group grid = cg::this_grid();
    const int wv = __builtin_amdgcn_readfirstlane(threadIdx.x >> 6);
    if (P.ph_lo < 0) grid.sync();
    unsigned char* ws = P.ws; unsigned char* dob = (unsigned char*)P.out;
    const int lo = P.ph_lo, hi = P.ph_hi;
    volatile LAS unsigned* xst = (volatile LAS unsigned*)(lds + 139264);
    if (TIDX(wv) < 2) xst[TIDX(wv)] = 0u;
    __syncthreads();
    const XcdBarrier xbar = xcd_barrier_post((unsigned*)(ws + WS_CTL), xst, TIDX(wv));
#define IN(k) (lo <= (k) && (k) < hi)
#define SEAM(k) do { if (IN(k) && IN((k) + 1)) { xcd_barrier(xbar, TIDX(wv)); if constexpr (((PROBE_DUP >> 10) & 1) != 0) xcd_barrier(xbar, TIDX(wv)); } } while (0)
    bf16* H = (bf16*)(ws + WS_H);
    if (IN(0)) { DUPK(0, phase_prep(P, lds, wv);) } SEAM(0);
    if (IN(1)) { DUPK(1,
        pg8::Gemm g{H, (const bf16*)(ws + WS_WIN), T, 2816, 1024}; pg8::StaticOrder S; S.init(T, 2816, gridDim.x, blockIdx.x);
        pg8::EpiInProj E{(bf16*)(dob + DO_CQ), (bf16*)(dob + DO_CKV), (bf16*)(ws + WS_HQ), (bf16*)(ws + WS_HI), (bf16*)(ws + WS_SG), (float*)(ws + WS_KR), (float*)(ws + WS_LOGF), (float*)(ws + WS_SSQ), P.lbl};
        pg8::gemm_phase<pg8::EpiInProj, pg8::StaticOrder, true, true>(lds, g, S, E, wv);
        __syncthreads();
        prep_late_weights(P, lds, wv, 192 * (int)gridDim.x / 256);
    ) } SEAM(1);
    if (IN(2)) { DUPK(2,
        PG8_LAS float* X = (PG8_LAS float*)(lds + 131072);
        { pg8::Gemm g{(const bf16*)(dob + DO_CKV), (const bf16*)(ws + WS_WUKV), T, 1024, 256}; pg8::StaticOrder S; S.init(T, 1024, gridDim.x, blockIdx.x);
          pg8::EpiKV E{(bf16*)(ws + WS_K), (bf16*)(ws + WS_V), (const float*)(ws + WS_SSQ), (const float*)(ws + WS_TAB), (const float*)(ws + WS_KR), P.kn_g, X};
          pg8::gemm_phase<pg8::EpiKV, pg8::StaticOrder, true, true>(lds, g, S, E, wv); }
        __syncthreads();
        { pg8::Gemm g{(const bf16*)(dob + DO_CQ), (const bf16*)(ws + WS_WUQ), T, 1024, 384}; pg8::StaticOrder S; S.init(T, 1024, gridDim.x, blockIdx.x);
          pg8::EpiQ E{(bf16*)(ws + WS_Q), (const float*)(ws + WS_SSQ), (const float*)(ws + WS_TAB), P.qn_g, X};
          pg8::gemm_phase<pg8::EpiQ, pg8::StaticOrder, true, true>(lds, g, S, E, wv); }
        __syncthreads();
        hgrn_local_phase(P, lds, wv);
        if constexpr (((PROBE_DUP >> 12) & 1) != 0) { __syncthreads(); hgrn_local_phase(P, lds, wv); }
    ) } SEAM(2);
    if (IN(3)) { hgrn_scan(P, wv); __syncthreads(); DUPK(3, phase_attn(P, lds, wv);) } SEAM(3);
    if (IN(4)) { DUPK(4,
        hgrn_out_phase(P, lds, wv);
        if constexpr (((PROBE_DUP >> 11) & 1) != 0) { __syncthreads(); hgrn_out_phase(P, lds, wv); }
        __syncthreads();
        pg8::Gemm g{H, (const bf16*)(ws + WS_WIN) + (size_t)2816 * 1024, T, 2048, 1024}; pg8::StaticOrder S; S.init(T, 2048, gridDim.x, blockIdx.x);
        pg8::EpiSigmoid E{(bf16*)(ws + WS_GATES), 2048};
        pg8::gemm_phase<pg8::EpiSigmoid, pg8::StaticOrder, true, true>(lds, g, S, E, wv);
    ) } SEAM(4);
    if (IN(5)) { DUPK(5,
        pg8::Gemm g{(const bf16*)(ws + WS_ATT), (const bf16*)(ws + WS_WBA), T, 1024, 512, (const bf16*)(ws + WS_REC), (const bf16*)(ws + WS_WBB)}; pg8::DualOrder S; S.init(T, 1024, gridDim.x, blockIdx.x);
        pg8::EpiGate2 E{H, (const bf16*)(ws + WS_GATES)};
        pg8::gemm_phase<pg8::EpiGate2, pg8::DualOrder, true, true>(lds, g, S, E, wv);
    ) } SEAM(5);
    if (IN(6)) { DUPK(6,
        pg8::Gemm g{H, (const bf16*)(ws + WS_WOUT), T, 1024, 1024}; pg8::StaticOrder S; S.init(T, 1024, gridDim.x, blockIdx.x);
        pg8::EpiResidX E{P.x, (bf16*)(ws + WS_LOGF), (float*)(ws + WS_SS1)};
        pg8::gemm_phase<pg8::EpiResidX, pg8::StaticOrder, true, true>(lds, g, S, E, wv);
    ) } SEAM(6);
    if (IN(7)) { DUPK(7,
        pg8::Gemm g{(const bf16*)(ws + WS_LOGF), (const bf16*)(ws + WS_WGU), T, 5632, 1024}; pg8::StaticOrder S; S.init(T, 5632, gridDim.x, blockIdx.x);
        pg8::EpiSwiGLU E{(bf16*)(ws + WS_ACT), (const float*)(ws + WS_SS1)};
        pg8::gemm_phase<pg8::EpiSwiGLU, pg8::StaticOrder, true, true>(lds, g, S, E, wv);
        __syncthreads();
        { pg8::Gemm g2{(const bf16*)(ws + WS_PB), (const bf16*)(ws + WS_WPP), T, 1024, 256}; pg8::SubOrder S2; S2.init(T, 1024, gridDim.x, blockIdx.x, (int)gridDim.x / 2);
          pg8::EpiPE E2{(bf16*)(ws + WS_ATT), (float*)(ws + WS_SSP)};
          pg8::gemm_phase<pg8::EpiPE, pg8::SubOrder, true, true>(lds, g2, S2, E2, wv); }
        __syncthreads();
        prep_wd(P, lds, wv, (int)gridDim.x / 2);
    ) } SEAM(7);
    if (IN(8)) {
        pg8::Gemm g{(const bf16*)(ws + WS_ACT), (const bf16*)(ws + WS_WD), T, 1024, 2816}; pg8::StaticOrder S; S.init(T, 1024, gridDim.x, blockIdx.x);
        pg8::EpiResidB E{(const bf16*)(ws + WS_LOGF), H, (float*)(ws + WS_SS2)};
        pg8::gemm_phase<pg8::EpiResidB, pg8::StaticOrder, true, true>(lds, g, S, E, wv);
    } SEAM(8);
    if (IN(9)) {
        pg8::Gemm g{H, (const bf16*)(ws + WS_WPG), T, 1024, 1024}; pg8::StaticOrder S; S.init(T, 1024, gridDim.x, blockIdx.x);
        pg8::EpiFinal E{P.out, H, (const bf16*)(ws + WS_ATT), (const float*)(ws + WS_SS2), (const float*)(ws + WS_SSP), P.pp_g};
        pg8::gemm_phase<pg8::EpiFinal, pg8::StaticOrder, true, true>(lds, g, S, E, wv);
    }
#undef IN
#undef SEAM
}

extern "C" void kernel_launch(void* const* d_in, const int* in_sizes, int n_in, void* d_out, int out_size, void* d_ws, size_t ws_size, hipStream_t stream) {
    static int grid = 0;
    if (!grid) {
        if (hipFuncSetAttribute((const void*)fwd, hipFuncAttributeMaxDynamicSharedMemorySize, LDS_BYTES) != hipSuccess) fprintf(stderr, "kernel_launch: hipFuncSetAttribute failed\n");
        int dev = 0, cus = 0;
        if (hipGetDevice(&dev) != hipSuccess || hipDeviceGetAttribute(&cus, hipDeviceAttributeMultiprocessorCount, dev) != hipSuccess || cus <= 0) cus = 256;
        (void)hipGetLastError();
        grid = cus;
    }
    Params P{};
    P.x = (const float*)d_in[0]; P.p = (const float*)d_in[1]; P.pos = (const int*)d_in[2];
    P.mix_g = (const float*)d_in[3]; P.w_in = (const float*)d_in[4]; P.qa_g = (const float*)d_in[5]; P.w_uq = (const float*)d_in[6]; P.kva_g = (const float*)d_in[7]; P.w_ukv = (const float*)d_in[8];
    P.qn_g = (const float*)d_in[9]; P.kn_g = (const float*)d_in[10]; P.lbl = (const float*)d_in[11]; P.hgo_g = (const float*)d_in[12]; P.w_br = (const float*)d_in[13]; P.w_out = (const float*)d_in[14];
    P.ffn_g = (const float*)d_in[15]; P.w_fg = (const float*)d_in[16]; P.w_fu = (const float*)d_in[17]; P.w_fd = (const float*)d_in[18]; P.pg_g = (const float*)d_in[19]; P.w_pg = (const float*)d_in[20];
    P.w_pp = (const float*)d_in[21]; P.pp_g = (const float*)d_in[22];
    P.out = (float*)d_out; P.ws = (unsigned char*)d_ws;
    P.ph_lo = 0; P.ph_hi = NPHASE;
    (void)hipMemsetAsync((unsigned char*)d_ws + WS_CTL, 0, 16384, stream);
    void* args[] = {&P};
    hipError_t e = hipLaunchCooperativeKernel((const void*)fwd, dim3(grid), dim3(512), args, LDS_BYTES, stream);
    if (e != hipSuccess) fprintf(stderr, "cooperative launch failed: %s (grid %d)\n", hipGetErrorString(e), grid);
}
```
